# Optimizing an MI355X kernel written in HIP

```python
import math
import jax, jax.numpy as jnp
from jax import lax
import numpy as np

D_MODEL = 4096
BATCH = 2
SEQ = 8192
DEPTH = 2

GRID_W = 64
CTX_LEN = 256
N_MOD = 9
N_BRANCH = 4
BRANCH_W = D_MODEL // 4
S5_GROUP = 16
S5_GROUPS = BRANCH_W // S5_GROUP
S5_STATE = 64
CONV_W = 3
POOL_WINDOWS = (2, 4, 8, 16)
POOL_GROUP_W = BRANCH_W // len(POOL_WINDOWS)
MLSTM_HEADS = 4
MLSTM_DV = BRANCH_W // MLSTM_HEADS
MLSTM_DK = MLSTM_DV // 2
MLSTM_CHUNK = 64
D_FF = 3 * D_MODEL // 2
EPS = 1e-6
F32 = jnp.float32
IN_SPLITS = (
    BRANCH_W,
    BRANCH_W, BRANCH_W, BRANCH_W,
    BRANCH_W,
    MLSTM_HEADS * MLSTM_DK, MLSTM_HEADS * MLSTM_DK,
    BRANCH_W, BRANCH_W,
    4 * MLSTM_HEADS,
    N_BRANCH * D_MODEL,
)
D_IN = sum(IN_SPLITS)

kernel_name = 'hybrid_s5_conv_pool_mlstm_prefix_dit_block'


def _split_cols(z):
    offsets = []
    acc = 0
    for s in IN_SPLITS[:-1]:
        acc += s
        offsets.append(acc)
    return jnp.split(z, offsets, axis=-1)


def _rms_norm(x):
    xf = x.astype(F32)
    return (xf * lax.rsqrt(jnp.mean(xf * xf, axis=-1, keepdims=True) + EPS)).astype(x.dtype)


def _modulate(xn, shift, scale):
    return xn * (1.0 + scale) + shift


def _swiglu(u, w_i, w_o):
    a, g = jnp.split(u @ w_i, 2, axis=-1)
    return (jax.nn.silu(g) * a) @ w_o


def _ffn_sublayer(h, shift, scale, gate, w_i, w_o):
    return h + 0.5 * gate * _swiglu(_modulate(_rms_norm(h), shift, scale), w_i, w_o)


def _raster_to_column(u):
    b, t, ch = u.shape
    rows = t // GRID_W
    return u.reshape(b, rows, GRID_W, ch).transpose(0, 2, 1, 3).reshape(b, t, ch)


def _column_to_raster(u):
    b, t, ch = u.shape
    rows = t // GRID_W
    return u.reshape(b, GRID_W, rows, ch).transpose(0, 2, 1, 3).reshape(b, t, ch)


def _s5_discretise(a_re, a_im, log_dt, b_re, b_im):
    a_re, a_im = a_re.astype(F32), a_im.astype(F32)
    dt = jnp.exp(log_dt.astype(F32))[:, None]
    mag = jnp.exp(dt * a_re)
    lam_re, lam_im = mag * jnp.cos(dt * a_im), mag * jnp.sin(dt * a_im)
    den = a_re * a_re + a_im * a_im
    z_re = ((lam_re - 1.0) * a_re + lam_im * a_im) / den
    z_im = (lam_im * a_re - (lam_re - 1.0) * a_im) / den
    b_re, b_im = b_re.astype(F32), b_im.astype(F32)
    bb_re = z_re[..., None] * b_re - z_im[..., None] * b_im
    bb_im = z_re[..., None] * b_im + z_im[..., None] * b_re
    return lam_re, lam_im, bb_re, bb_im


def _cdiag_combine(e1, e2):
    a1r, a1i, b1r, b1i = e1
    a2r, a2i, b2r, b2i = e2
    return (a2r * a1r - a2i * a1i, a2r * a1i + a2i * a1r,
            a2r * b1r - a2i * b1i + b2r, a2r * b1i + a2i * b1r + b2i)


def _s5_time_major(u):
    b, t, _ = u.shape
    return jnp.moveaxis(u.astype(F32).reshape(b, t, S5_GROUPS, S5_GROUP), 1, 0)


def _s5_states(u_tm, disc, x0, reverse):
    lam_re, lam_im, bb_re, bb_im = disc
    bu_re = jnp.einsum('tbgp,gnp->tbgn', u_tm, bb_re)
    bu_im = jnp.einsum('tbgp,gnp->tbgn', u_tm, bb_im)
    if reverse:
        bu_re, bu_im = bu_re[::-1], bu_im[::-1]
    x0_re, x0_im = x0
    bu_re = bu_re.at[0].add(lam_re * x0_re - lam_im * x0_im)
    bu_im = bu_im.at[0].add(lam_re * x0_im + lam_im * x0_re)
    t = u_tm.shape[0]
    a_re = jnp.broadcast_to(lam_re, (t, 1) + lam_re.shape)
    a_im = jnp.broadcast_to(lam_im, (t, 1) + lam_im.shape)
    _, _, x_re, x_im = lax.associative_scan(_cdiag_combine, (a_re, a_im, bu_re, bu_im), axis=0)
    final = (x_re[-1], x_im[-1])
    if reverse:
        x_re, x_im = x_re[::-1], x_im[::-1]
    return x_re, x_im, final


def _s5_readout(x_re, x_im, c_re, c_im):
    return jnp.einsum('tbgn,gpn->tbgp', x_re, c_re) - jnp.einsum('tbgn,gpn->tbgp', x_im, c_im)


def _s5_glu(y_tm, w_glu, b_glu):
    t, b = y_tm.shape[:2]
    y = jnp.moveaxis(y_tm, 0, 1).reshape(b, t, BRANCH_W)
    g = jax.nn.gelu(y)
    return g * jax.nn.sigmoid(g @ w_glu.astype(F32) + b_glu.astype(F32))


def s5_branch(u_lat, u_ctx, with_ctx_out, a_re, a_im, log_dt, b_re, b_im, c_re, c_im, d_skip, w_glu, b_glu):
    ul = _s5_time_major(u_lat)
    uc = _s5_time_major(u_ctx)
    zero = jnp.zeros((u_ctx.shape[0], S5_GROUPS, S5_STATE), F32)
    d_mat = d_skip.astype(F32).reshape(S5_GROUPS, S5_GROUP)
    y_lat = d_mat * ul
    y_ctx = d_mat * uc if with_ctx_out else None
    for di, rev in enumerate((False, True)):
        disc = _s5_discretise(a_re[di], a_im[di], log_dt[di], b_re[di], b_im[di])
        cr, ci = c_re[di].astype(F32), c_im[di].astype(F32)
        xc_re, xc_im, fin = _s5_states(uc, disc, (zero, zero), rev)
        xl_re, xl_im, _ = _s5_states(ul, disc, fin, rev)
        y_lat = y_lat + _s5_readout(xl_re, xl_im, cr, ci)
        if with_ctx_out:
            y_ctx = y_ctx + _s5_readout(xc_re, xc_im, cr, ci)
    out_lat = _s5_glu(y_lat, w_glu, b_glu).astype(u_lat.dtype)
    out_ctx = _s5_glu(y_ctx, w_glu, b_glu).astype(u_ctx.dtype) if with_ctx_out else None
    return out_lat, out_ctx


def conv_branch(h, b_gate, c_gate, conv_w):
    xg = c_gate * h
    t = xg.shape[1]
    pad = CONV_W // 2
    xp = jnp.pad(xg, ((0, 0), (pad, pad), (0, 0)))
    y = conv_w[0] * xp[:, 0:t]
    for j in range(1, CONV_W):
        y = y + conv_w[j] * xp[:, j:j + t]
    return b_gate * y


def pool_branch(u, pool_w, pool_scale):
    b, t, _ = u.shape
    uf = u.astype(F32).reshape(b, t, len(POOL_WINDOWS), POOL_GROUP_W)
    cs = jnp.concatenate([jnp.zeros((b, 1) + uf.shape[2:], F32), jnp.cumsum(uf, axis=1)], axis=1)
    pos = jnp.arange(t)
    outs = []
    for gi, win in enumerate(POOL_WINDOWS):
        lo = jnp.clip(pos - win // 2, 0, t)
        hi = jnp.clip(pos + win - win // 2, 0, t)
        csg = cs[:, :, gi]
        mean = (csg[:, hi] - csg[:, lo]) / (hi - lo).astype(F32)[None, :, None]
        outs.append(mean - uf[:, :, gi])
    p = jnp.stack(outs, axis=2)
    y = jnp.einsum('btgc,gcd->btgd', p, pool_w.astype(F32)).reshape(b, t, BRANCH_W)
    return (y * pool_scale.astype(F32)).astype(u.dtype)


def _mlstm_chunk_scan(q, k, v, log_i, log_f, state):
    b, nh, t, _ = q.shape
    nc = t // MLSTM_CHUNK

    def to_chunks(a):
        return jnp.moveaxis(a.reshape(a.shape[:2] + (nc, MLSTM_CHUNK) + a.shape[3:]), 2, 0)

    causal = jnp.tril(jnp.ones((MLSTM_CHUNK, MLSTM_CHUNK), dtype=bool))

    def step(carry, blk):
        c_mat, n_vec, m = carry
        qc, kc, vc, lic, lfc = blk
        bcum = jnp.cumsum(lfc, axis=-1)
        dmat = jnp.where(causal, bcum[..., :, None] - bcum[..., None, :] + lic[..., None, :], -jnp.inf)
        m_inter = bcum + m[..., None]
        m_t = jnp.maximum(jnp.max(dmat, axis=-1), m_inter)
        w = jnp.einsum('bhtd,bhsd->bhts', qc, kc) * jnp.exp(dmat - m_t[..., None])
        decay = jnp.exp(m_inter - m_t)
        num = jnp.einsum('bhts,bhsv->bhtv', w, vc) + decay[..., None] * jnp.einsum('bhtd,bhdv->bhtv', qc, c_mat)
        den = jnp.sum(w, axis=-1) + decay * jnp.einsum('bhtd,bhd->bht', qc, n_vec)
        h = num / jnp.maximum(jnp.abs(den), jnp.exp(-m_t))[..., None]
        b_last = bcum[..., -1]
        g = b_last[..., None] - bcum + lic
        m_new = jnp.maximum(b_last + m, jnp.max(g, axis=-1))
        carry_decay = jnp.exp(b_last + m - m_new)
        wk = kc * jnp.exp(g - m_new[..., None])[..., None]
        c_new = carry_decay[..., None, None] * c_mat + jnp.einsum('bhsd,bhsv->bhdv', wk, vc)
        n_new = carry_decay[..., None] * n_vec + jnp.sum(wk, axis=-2)
        return (c_new, n_new, m_new), h

    xs = (to_chunks(q), to_chunks(k), to_chunks(v), to_chunks(log_i), to_chunks(log_f))
    final, hs = lax.scan(step, state, xs)
    h = jnp.moveaxis(hs, 0, 2).reshape(b, nh, t, hs.shape[-1])
    return h, final


def _mlstm_direction(q, k, v, log_i, log_f, state, reverse):
    if reverse:
        q, k, v = q[:, :, ::-1], k[:, :, ::-1], v[:, :, ::-1]
        log_i, log_f = log_i[..., ::-1], log_f[..., ::-1]
    h, final = _mlstm_chunk_scan(q, k, v, log_i, log_f, state)
    if reverse:
        h = h[:, :, ::-1]
    return h, final


def _mlstm_heads(z, gate_bias):
    q, k, v, _, g = z
    b, t, _ = q.shape

    def split_heads(a, dh):
        return a.astype(F32).reshape(b, t, MLSTM_HEADS, dh).transpose(0, 2, 1, 3)

    qh = split_heads(q, MLSTM_DK) * (MLSTM_DK ** -0.5)
    kh = split_heads(k, MLSTM_DK)
    vh = split_heads(v, MLSTM_DV)
    pre = (g.astype(F32) + gate_bias.astype(F32).reshape(-1)).reshape(b, t, 4, MLSTM_HEADS).transpose(2, 0, 3, 1)
    log_i = (pre[0], pre[1])
    log_f = (jax.nn.log_sigmoid(pre[2]), jax.nn.log_sigmoid(pre[3]))
    return qh, kh, vh, log_i, log_f


def _mlstm_readout(h, o, norm_gain):
    b, nh, t, dv = h.shape
    hn = h * lax.rsqrt(jnp.mean(h * h, axis=-1, keepdims=True) + EPS)
    hn = hn.transpose(0, 2, 1, 3).reshape(b, t, nh * dv) * norm_gain.astype(F32)
    return (hn * jax.nn.sigmoid(o.astype(F32))).astype(o.dtype)


def mlstm_branch(z_lat, z_ctx, with_ctx_out, gate_bias, norm_gain):
    ql, kl, vl, il, fl = _mlstm_heads(z_lat, gate_bias)
    qc, kc, vc, ic, fc = _mlstm_heads(z_ctx, gate_bias)
    b = qc.shape[0]
    zero = (jnp.zeros((b, MLSTM_HEADS, MLSTM_DK, MLSTM_DV), F32),
            jnp.zeros((b, MLSTM_HEADS, MLSTM_DK), F32),
            jnp.zeros((b, MLSTM_HEADS), F32))
    h_lat, h_ctx = [], []
    for di, rev in enumerate((False, True)):
        hc, fin = _mlstm_direction(qc, kc, vc, ic[di], fc[di], zero, rev)
        hl, _ = _mlstm_direction(ql, kl, vl, il[di], fl[di], fin, rev)
        h_lat.append(hl)
        h_ctx.append(hc)
    out_lat = _mlstm_readout(h_lat[0] + h_lat[1], z_lat[3], norm_gain)
    out_ctx = _mlstm_readout(h_ctx[0] + h_ctx[1], z_ctx[3], norm_gain) if with_ctx_out else None
    return out_lat, out_ctx


def _merge_branches(branches, gate_pre, w_branch, w_out):
    gates = jax.nn.sigmoid(gate_pre.astype(F32)).astype(gate_pre.dtype)
    merged = gates[..., 0:D_MODEL] * (branches[0] @ w_branch[0])
    for i in range(1, N_BRANCH):
        merged = merged + gates[..., i * D_MODEL:(i + 1) * D_MODEL] * (branches[i] @ w_branch[i])
    return merged @ w_out


def token_mixer(u_lat, u_ctx, with_ctx_out, lp):
    zl = _split_cols(u_lat @ lp['w_in'])
    zc = _split_cols(u_ctx @ lp['w_in'])
    s5_l, s5_c = s5_branch(zl[0], zc[0], with_ctx_out, lp['s5_a_re'], lp['s5_a_im'], lp['s5_log_dt'],
                           lp['s5_b_re'], lp['s5_b_im'], lp['s5_c_re'], lp['s5_c_im'], lp['s5_d'],
                           lp['s5_w_glu'], lp['s5_b_glu'])
    ml_l, ml_c = mlstm_branch(zl[5:10], zc[5:10], with_ctx_out, lp['mlstm_gate_bias'], lp['mlstm_norm_gain'])
    conv_l = conv_branch(zl[1], zl[2], zl[3], lp['conv_w'])
    pool_l = pool_branch(zl[4], lp['pool_w'], lp['pool_scale'])
    y_lat = _merge_branches((s5_l, conv_l, pool_l, ml_l), zl[10], lp['w_branch'], lp['w_out'])
    if not with_ctx_out:
        return y_lat, None
    conv_c = conv_branch(zc[1], zc[2], zc[3], lp['conv_w'])
    pool_c = pool_branch(zc[4], lp['pool_w'], lp['pool_scale'])
    y_ctx = _merge_branches((s5_c, conv_c, pool_c, ml_c), zc[10], lp['w_branch'], lp['w_out'])
    return y_lat, y_ctx


def setup_inputs(seed: int = 0) -> dict:
    key = jax.random.key(seed)
    ks = iter(jax.random.split(key, 40))

    def nrm(shape, scale):
        return jax.random.normal(next(ks), shape, F32) * scale

    L, D, W, G, N, P, H = DEPTH, D_MODEL, BRANCH_W, S5_GROUPS, S5_STATE, S5_GROUP, MLSTM_HEADS
    a_im_base = math.pi * jnp.arange(N, dtype=F32)
    f_bias = jnp.broadcast_to(jnp.linspace(3.0, 6.0, H, dtype=F32), (2, H))
    gate_offsets = jnp.concatenate([jnp.zeros((2, H), F32), f_bias], axis=0)
    return {
        'x': nrm((BATCH, SEQ, D), 1.0),
        'c': nrm((BATCH, D), 1.0),
        'ctx': nrm((BATCH, CTX_LEN, D), 1.0),
        'c_ctx': nrm((D,), 1.0),
        'w_ada': nrm((L, D, N_MOD * D), 0.5 * D ** -0.5),
        'b_ada': nrm((L, N_MOD * D), 0.02),
        'w_ffn1_in': nrm((L, D, 2 * D_FF), D ** -0.5),
        'w_ffn1_out': nrm((L, D_FF, D), D_FF ** -0.5),
        'w_ffn2_in': nrm((L, D, 2 * D_FF), D ** -0.5),
        'w_ffn2_out': nrm((L, D_FF, D), D_FF ** -0.5),
        'w_in': nrm((L, D, D_IN), D ** -0.5),
        's5_a_re': -0.5 + nrm((L, 2, G, N), 0.01),
        's5_a_im': a_im_base + nrm((L, 2, G, N), 0.01),
        's5_log_dt': jax.random.uniform(next(ks), (L, 2, G), F32, math.log(1e-3), math.log(1e-1)),
        's5_b_re': nrm((L, 2, G, N, P), (2 * P) ** -0.5),
        's5_b_im': nrm((L, 2, G, N, P), (2 * P) ** -0.5),
        's5_c_re': nrm((L, 2, G, P, N), 2 ** -0.5),
        's5_c_im': nrm((L, 2, G, P, N), 2 ** -0.5),
        's5_d': nrm((L, W), 1.0),
        's5_w_glu': nrm((L, W, W), W ** -0.5),
        's5_b_glu': nrm((L, W), 0.02),
        'conv_w': nrm((L, CONV_W, W), CONV_W ** -0.5),
        'pool_w': nrm((L, len(POOL_WINDOWS), POOL_GROUP_W, POOL_GROUP_W), POOL_GROUP_W ** -0.5),
        'pool_scale': 0.5 + nrm((L, W), 0.05),
        'mlstm_gate_bias': gate_offsets + nrm((L, 4, H), 0.1),
        'mlstm_norm_gain': 1.0 + nrm((L, W), 0.02),
        'w_branch': nrm((L, N_BRANCH, W, D), W ** -0.5),
        'w_out': nrm((L, D, D), D ** -0.5),
        'final_gain': 1.0 + nrm((D,), 0.02),
    }


def reference(x, c, ctx, c_ctx, w_ada, b_ada, w_ffn1_in, w_ffn1_out, w_ffn2_in, w_ffn2_out, w_in,
              s5_a_re, s5_a_im, s5_log_dt, s5_b_re, s5_b_im, s5_c_re, s5_c_im, s5_d, s5_w_glu, s5_b_glu,
              conv_w, pool_w, pool_scale, mlstm_gate_bias, mlstm_norm_gain, w_branch, w_out, final_gain):
    h, hc = x, ctx
    c_act = jax.nn.silu(c)
    cc_act = jax.nn.silu(c_ctx)
    for l in range(DEPTH):
        last = l == DEPTH - 1
        mod = [m[:, None, :] for m in jnp.split(c_act @ w_ada[l] + b_ada[l], N_MOD, axis=-1)]
        modc = jnp.split(cc_act @ w_ada[l] + b_ada[l], N_MOD, axis=-1)
        h = _ffn_sublayer(h, mod[0], mod[1], mod[2], w_ffn1_in[l], w_ffn1_out[l])
        hc = _ffn_sublayer(hc, modc[0], modc[1], modc[2], w_ffn1_in[l], w_ffn1_out[l])
        u = _modulate(_rms_norm(h), mod[3], mod[4])
        uc = _modulate(_rms_norm(hc), modc[3], modc[4])
        col_major = (l % 2) == 1
        if col_major:
            u = _raster_to_column(u)
        lp = {
            'w_in': w_in[l], 's5_a_re': s5_a_re[l], 's5_a_im': s5_a_im[l], 's5_log_dt': s5_log_dt[l],
            's5_b_re': s5_b_re[l], 's5_b_im': s5_b_im[l], 's5_c_re': s5_c_re[l], 's5_c_im': s5_c_im[l],
            's5_d': s5_d[l], 's5_w_glu': s5_w_glu[l], 's5_b_glu': s5_b_glu[l], 'conv_w': conv_w[l],
            'pool_w': pool_w[l], 'pool_scale': pool_scale[l], 'mlstm_gate_bias': mlstm_gate_bias[l],
            'mlstm_norm_gain': mlstm_norm_gain[l], 'w_branch': w_branch[l], 'w_out': w_out[l],
        }
        y, yc = token_mixer(u, uc, not last, lp)
        if col_major:
            y = _column_to_raster(y)
        h = h + mod[5] * y
        h = _ffn_sublayer(h, mod[6], mod[7], mod[8], w_ffn2_in[l], w_ffn2_out[l])
        if not last:
            hc = hc + modc[5] * yc
            hc = _ffn_sublayer(hc, modc[6], modc[7], modc[8], w_ffn2_in[l], w_ffn2_out[l])
    return _rms_norm(h) * final_gain
```

```cpp
#include <hip/hip_runtime.h>
#include <cstdio>
#include <cstdint>

#ifndef MK_ONE_LAUNCH
#define MK_ONE_LAUNCH 1
#endif

#define LAS __attribute__((address_space(3)))
typedef __attribute__((address_space(1))) unsigned char gchar_t;
typedef unsigned short bf16_t;
typedef short bf16x8 __attribute__((ext_vector_type(8)));
typedef float f32x4 __attribute__((ext_vector_type(4)));
typedef float f32x2 __attribute__((ext_vector_type(2)));
typedef unsigned u32x4 __attribute__((ext_vector_type(4)));
typedef unsigned u32x2 __attribute__((ext_vector_type(2)));

constexpr int D = 4096, NB = 2, T = 8192, CT = 256, NL = 2;
constexpr int ML = NB * T;
constexpr int MC = NB * CT;
constexpr int MT = ML + MC;
constexpr int DFF = 6144, BW = 1024, NMOD = 9, NADA = NMOD * D;
constexpr int NIN = 24592, NINP = 24832;
constexpr int ZW = 8192;
constexpr int GW = 16384;
constexpr int HEADS = 4, DK = 128, DV = 256, CHK = 64;
constexpr int NCHK = (T + CT) / CHK;
constexpr int S5G = 64, S5P = 16, S5N = 64;
constexpr float EPS = 1e-6f;
constexpr int ZC_S5 = 0, ZC_CH = 1024, ZC_CB = 2048, ZC_CC = 3072, ZC_PL = 4096, ZC_Q = 5120, ZC_K = 5632, ZC_V = 6144, ZC_O = 7168;

constexpr size_t MiB = 1u << 20;
constexpr size_t al(size_t x) { return (x + 255) & ~(size_t)255; }
constexpr size_t WS_CTL = 0, CTL_BYTES = 1 * MiB;
constexpr size_t WS_MOD = WS_CTL + CTL_BYTES;
constexpr size_t WS_W1IN = al(WS_MOD + (size_t)NL * 3 * NADA * 4);
constexpr size_t SZ_WFIN = (size_t)2 * DFF * D * 2;
constexpr size_t WS_W1OUT = al(WS_W1IN + (size_t)NL * 2 * SZ_WFIN);
constexpr size_t SZ_WFOUT = (size_t)D * DFF * 2;
constexpr size_t WS_WIN = al(WS_W1OUT + (size_t)NL * 2 * SZ_WFOUT);
constexpr size_t SZ_WIN = (size_t)NINP * D * 2;
constexpr size_t WS_WGLU = al(WS_WIN + (size_t)NL * SZ_WIN);
constexpr size_t SZ_WGLU = (size_t)BW * BW * 2;
constexpr size_t WS_WPOOL = al(WS_WGLU + (size_t)NL * SZ_WGLU);
constexpr size_t SZ_WPOOL = (size_t)BW * 256 * 2;
constexpr size_t WS_WBR = al(WS_WPOOL + (size_t)NL * SZ_WPOOL);
constexpr size_t SZ_WSQ = (size_t)D * D * 2;
constexpr size_t WS_WOUT = al(WS_WBR + (size_t)NL * SZ_WSQ);
constexpr size_t WS_H = al(WS_WOUT + (size_t)NL * SZ_WSQ);
constexpr size_t WS_U = al(WS_H + (size_t)MT * D * 4);
constexpr int HIDP = DFF + 128;
constexpr size_t WS_HID = al(WS_U + (size_t)MT * D * 2);
constexpr size_t WS_Z = al(WS_HID + (size_t)MT * HIDP * 2);
constexpr size_t WS_GATES = al(WS_Z + (size_t)MT * ZW * 2);
constexpr size_t WS_G = al(WS_GATES + (size_t)MT * 16 * 4);
constexpr size_t WS_BR = al(WS_G + (size_t)MT * GW * 2);
constexpr size_t WS_MRG = al(WS_BR + (size_t)MT * D * 2);
constexpr size_t WS_YP = al(WS_MRG + (size_t)MT * D * 4);
constexpr size_t WS_GS5 = al(WS_YP + (size_t)2 * MT * BW * 4);
constexpr size_t WS_PL = al(WS_GS5 + (size_t)MT * BW * 2);
constexpr size_t WS_CIN = al(WS_PL + (size_t)MT * BW * 2);
constexpr size_t WS_NIN = al(WS_CIN + (size_t)16 * NCHK * DK * DV * 2);
constexpr size_t WS_MIN = al(WS_NIN + (size_t)16 * NCHK * DK * 4);
constexpr size_t WS_KC = al(WS_MIN + (size_t)16 * NCHK * 4);
constexpr size_t WS_VC = al(WS_KC + (size_t)HEADS * 8 * MT * 16 * 2);
constexpr size_t WS_ADAP = al(WS_VC + (size_t)HEADS * 16 * MT * 16 * 2);
constexpr size_t WS_END = al(WS_ADAP + (size_t)NL * 16 * 3 * NADA * 4);

typedef __bf16 bf16x2_t __attribute__((ext_vector_type(2)));
__device__ __forceinline__ unsigned pk2(float lo, float hi) { f32x2 v = {lo, hi}; bf16x2_t b = __builtin_convertvector(v, bf16x2_t); return __builtin_bit_cast(unsigned, b); }
__device__ __forceinline__ float bflo(unsigned w) { return __uint_as_float(w << 16); }
__device__ __forceinline__ float bfhi(unsigned w) { return __uint_as_float(w & 0xffff0000u); }
__device__ __forceinline__ float bf1(bf16_t b) { return __uint_as_float((unsigned)b << 16); }
__device__ __forceinline__ float wave_sum(float v) {
#pragma unroll
    for (int o = 1; o < 64; o <<= 1) v += __shfl_xor(v, o);
    return v;
}
__device__ __forceinline__ float wave_max(float v) {
#pragma unroll
    for (int o = 1; o < 64; o <<= 1) v = fmaxf(v, __shfl_xor(v, o));
    return v;
}
__device__ __forceinline__ float sigm(float x) { return __builtin_amdgcn_rcpf(1.f + __expf(-x)); }
__device__ __forceinline__ float siluf_(float x) { return x * sigm(x); }
__device__ __forceinline__ float gelu_tanh(float x) { const float z = 0.7978845608028654f * (x + 0.044715f * x * x * x); return x * sigm(2.f * z); }
__device__ __forceinline__ float logsigmoid(float x) { return fminf(x, 0.f) - log1pf(expf(-fabsf(x))); }
#define LDS_WAIT() asm volatile("s_waitcnt lgkmcnt(0)" ::: "memory")
#define VM_WAIT() asm volatile("s_waitcnt vmcnt(0)" ::: "memory")

namespace pg8 {
constexpr int BM = 256, BK = 64, HALF = 128, HTB = HALF * BK * 2, STAGE_BYTES = 8 * HTB, NXCD = 8, WGM = 4;
__host__ __device__ __forceinline__ int lds_byte(int r, int c) { const int st = (r >> 4) * 2 + (c >> 5), rr = r & 15, cc = c & 31, ob = rr * 64 + cc * 2; return st * 1024 + (ob ^ (((ob >> 9) & 1) << 5)); }
__host__ __device__ __forceinline__ void stage_rc(int b, int& R, int& C) { const int st = b / 1024, sb = b % 1024, swz = sb ^ (((sb >> 9) & 1) << 5); R = (st >> 1) * 16 + swz / 64; C = (st & 1) * 32 + (swz % 64) / 2; }
__host__ __device__ __forceinline__ int perm32(int rho) { const int n = rho >> 4, i = rho & 15; return 8 * (i >> 2) + 4 * n + (i & 3); }

struct Unit { int pm, pn, kb; };
struct Gemm { const bf16_t* A; const bf16_t* Bt; int lda, ldb, K, a_pn_off; };

struct StaticOrder {
    int nM, nN, nwg, G, c, nmain, xM, xN, i0, i1;
    __device__ void init(int nM_, int nN_, int G_, int c_) { nM = nM_; nN = nN_; nmain = nM * nN; nwg = nmain; G = G_; c = c_; xM = 0; xN = 0; i0 = 0; i1 = 0x7fffffff; }
    __device__ void add_extra(int xM_, int xN_) { xM = xM_; xN = xN_; nwg = nmain + xM * xN; }
    static constexpr bool KB = false;
    __device__ bool next(int i, Unit& u) const {
        u.kb = 0;
        const int ii = i + i0; if (ii >= i1) return false;
        const long L = (long)ii * G + c; if (L >= nwg) return false;
        int wgid = (int)L; { const int q = nwg / NXCD, r = nwg % NXCD, xcd = wgid % NXCD, off = wgid / NXCD; wgid = (xcd < r ? xcd * (q + 1) : r * (q + 1) + (xcd - r) * q) + off; }
        if (wgid >= nmain) { const int e = wgid - nmain; u.pm = nM + e % xM; u.pn = e / xM; return true; }
        const int nig = WGM * nN, gid = wgid / nig, fm = gid * WGM, gsz = (nM - fm) < WGM ? (nM - fm) : WGM;
        u.pm = fm + ((wgid % nig) % gsz); u.pn = (wgid % nig) / gsz; return true;
    }
};
struct MergeOrder {
    StaticOrder S;
    static constexpr bool KB = true;
    __device__ bool next(int i, Unit& u) const { if (!S.next(i >> 2, u)) return false; u.kb = i & 3; return true; }
};

template <class Epi, class Order>
__device__ __forceinline__ void gemm_phase(LAS unsigned char* lds, const Gemm g, const Order& S, const Epi& E) {
    int tid_ = threadIdx.x; asm volatile("" : "+v"(tid_));
    const int tid = tid_, wid = __builtin_amdgcn_readfirstlane(tid >> 6), lane = tid & 63, wr = wid >> 2, wc = wid & 3, fr = lane & 15, fq = lane >> 4;
    const int K = g.K, nt = K / BK;
    unsigned voffA[2], voffB[2];
#pragma unroll
    for (int i = 0; i < 2; ++i) { int R, C; stage_rc(tid * 16 + i * 8192, R, C); const int Rb = Epi::PERM ? ((R & ~31) + perm32(R & 31)) : R;
        voffA[i] = (unsigned)(R * g.lda + C) * 2u; voffB[i] = (unsigned)(Rb * g.ldb + C) * 2u; }
    const size_t kstep = (size_t)(BK * 2);
    const size_t hstepA = (size_t)HALF * g.lda * 2, hstepB = (size_t)HALF * g.ldb * 2;
    const size_t tstepA = 2 * hstepA, tstepB = 2 * hstepB;
    const size_t pnA = (size_t)g.a_pn_off * 2;
    const unsigned ldsw = (unsigned)wid * 1024u;
    const int aoff = lds_byte(wr * 64 + fr, fq * 8), boff = lds_byte(wc * 32 + fr, fq * 8);
#define PG8_SA(b, h) (((b) * 2 + (h)) * HTB)
#define PG8_SB(b, h) ((4 + (b) * 2 + (h)) * HTB)
#define PG8_STAGE(bufoff, gbase, voff) do { const __amdgpu_buffer_rsrc_t r_ = __builtin_amdgcn_make_buffer_rsrc((void*)(gbase), 0, 0x7fffffff, 0x00020000); _Pragma("unroll") for (int _i = 0; _i < 2; ++_i) \
        __builtin_amdgcn_raw_ptr_buffer_load_lds(r_, (LAS void*)(lds + (bufoff) + ldsw + _i * 8192), 16, (voff)[_i], 0, 0, 0); } while (0)
#define PG8_LDA(dst, b, h) do { _Pragma("unroll") for (int m = 0; m < 4; ++m) _Pragma("unroll") for (int k = 0; k < 2; ++k) dst[m][k] = *(const LAS bf16x8*)(lds + PG8_SA(b, h) + aoff + m * 2048 + k * 1024); } while (0)
#define PG8_LDB(dst, b, h) do { _Pragma("unroll") for (int n = 0; n < 2; ++n) _Pragma("unroll") for (int k = 0; k < 2; ++k) dst[n][k] = *(const LAS bf16x8*)(lds + PG8_SB(b, h) + boff + n * 2048 + k * 1024); } while (0)
#define PG8_MMA(ai, bj, At, Bt) do { __builtin_amdgcn_s_setprio(1); _Pragma("unroll") for (int m = 0; m < 4; ++m) _Pragma("unroll") for (int n = 0; n < 2; ++n) _Pragma("unroll") for (int k = 0; k < 2; ++k) \
        acc[ai][bj][m][n] = __builtin_amdgcn_mfma_f32_16x16x32_bf16(Bt[n][k], At[m][k], acc[ai][bj][m][n], 0, 0, 0); __builtin_amdgcn_s_setprio(0); } while (0)
#define PG8_WAIT_V(n) asm volatile("s_waitcnt vmcnt(" #n ")" ::: "memory")
#define PG8_WAIT_L(n) asm volatile("s_waitcnt lgkmcnt(" #n ")" ::: "memory")
#define PG8_BAR __builtin_amdgcn_s_barrier()
#define PG8_SCHED __builtin_amdgcn_sched_barrier(0)
    Unit cur, nxt; int ui = 0;
    if (!S.next(0, cur)) return;
    f32x4 acc[2][2][4][2];
#pragma unroll
    for (int a = 0; a < 2; ++a)
#pragma unroll
        for (int b = 0; b < 2; ++b)
#pragma unroll
            for (int m = 0; m < 4; ++m)
#pragma unroll
                for (int n = 0; n < 2; ++n) acc[a][b][m][n] = (f32x4){0.f, 0.f, 0.f, 0.f};
    bf16x8 At[4][2], B0[2][2], B1[2][2];
    const size_t kbstep = Order::KB ? (size_t)K * 2 : 0;
    const char* cA = (const char*)g.A + (size_t)cur.pm * tstepA + (size_t)cur.pn * pnA + cur.kb * kbstep; const char* cB = (const char*)g.Bt + (size_t)cur.pn * tstepB + cur.kb * kbstep;
    PG8_STAGE(PG8_SB(0, 0), cB, voffB); PG8_STAGE(PG8_SB(0, 1), cB + hstepB, voffB); PG8_STAGE(PG8_SA(0, 0), cA, voffA); PG8_STAGE(PG8_SA(0, 1), cA + hstepA, voffA);
    if (wr == 1) PG8_BAR;
    PG8_WAIT_V(2); PG8_BAR;
    PG8_STAGE(PG8_SB(1, 0), cB + kstep, voffB); PG8_STAGE(PG8_SA(1, 0), cA + kstep, voffA); PG8_STAGE(PG8_SB(1, 1), cB + hstepB + kstep, voffB);
    PG8_WAIT_V(6); PG8_BAR;
    for (;;) {
        const bool has_next = S.next(ui + 1, nxt);
        const char* nA = has_next ? (const char*)g.A + (size_t)nxt.pm * tstepA + (size_t)nxt.pn * pnA + nxt.kb * kbstep : cA; const char* nB = has_next ? (const char*)g.Bt + (size_t)nxt.pn * tstepB + nxt.kb * kbstep : cB;
        for (int t = 0; t < nt; t += 2) {
            const bool last = (t == nt - 2);
            const char* a1 = cA + (size_t)(t + 1) * kstep;
            const char* a2 = last ? nA : cA + (size_t)(t + 2) * kstep; const char* b2 = last ? nB : cB + (size_t)(t + 2) * kstep;
            const char* a3 = a2 + kstep; const char* b3 = b2 + kstep;
            PG8_LDB(B0, 0, 0); PG8_LDB(B1, 0, 1); PG8_SCHED; PG8_LDA(At, 0, 0); PG8_STAGE(PG8_SA(1, 1), a1 + hstepA, voffA);
            PG8_WAIT_V(8); PG8_WAIT_L(0); PG8_BAR; PG8_MMA(0, 0, At, B0); PG8_MMA(0, 1, At, B1); PG8_BAR; PG8_SCHED;
            PG8_LDA(At, 0, 1); PG8_STAGE(PG8_SB(0, 0), b2, voffB); PG8_STAGE(PG8_SB(0, 1), b2 + hstepB, voffB); PG8_STAGE(PG8_SA(0, 0), a2, voffA);
            PG8_WAIT_V(8); PG8_WAIT_L(0); PG8_BAR; PG8_MMA(1, 0, At, B0); PG8_MMA(1, 1, At, B1); PG8_BAR; PG8_SCHED;
            PG8_LDB(B0, 1, 0); PG8_LDB(B1, 1, 1); PG8_SCHED; PG8_LDA(At, 1, 0); PG8_STAGE(PG8_SA(0, 1), a2 + hstepA, voffA);
            PG8_WAIT_V(8); PG8_WAIT_L(0); PG8_BAR; PG8_MMA(0, 0, At, B0); PG8_MMA(0, 1, At, B1); PG8_BAR; PG8_SCHED;
            PG8_LDA(At, 1, 1); PG8_STAGE(PG8_SB(1, 0), b3, voffB); PG8_STAGE(PG8_SB(1, 1), b3 + hstepB, voffB); PG8_STAGE(PG8_SA(1, 0), a3, voffA);
            PG8_WAIT_V(8); PG8_WAIT_L(0); PG8_BAR; PG8_MMA(1, 0, At, B0); PG8_MMA(1, 1, At, B1); PG8_BAR; PG8_SCHED;
        }
        if (wr == 0) PG8_BAR;
        E(acc, cur, wr, wc, fr, fq);
        if (!has_next) break;
#pragma unroll
        for (int a = 0; a < 2; ++a)
#pragma unroll
            for (int b = 0; b < 2; ++b)
#pragma unroll
                for (int m = 0; m < 4; ++m)
#pragma unroll
                    for (int n = 0; n < 2; ++n) acc[a][b][m][n] = (f32x4){0.f, 0.f, 0.f, 0.f};
        cur = nxt; cA = nA; cB = nB; ++ui;
        if (wr == 1) PG8_BAR;
    }
    PG8_WAIT_V(0);
    PG8_BAR;
#undef PG8_SA
#undef PG8_SB
#undef PG8_STAGE
#undef PG8_LDA
#undef PG8_LDB
#undef PG8_MMA
#undef PG8_WAIT_V
#undef PG8_WAIT_L
#undef PG8_BAR
#undef PG8_SCHED
}

}

__device__ __forceinline__ int seq2raster(int row) {
    if (row >= ML) return row;
    const int b = row >> 13, s = row & (T - 1), c = s >> 7, rw = s & 127;
    return (b << 13) + rw * 64 + c;
}
__device__ __forceinline__ int raster2seq(int row) {
    if (row >= ML) return row;
    const int b = row >> 13, t = row & (T - 1), rw = t >> 6, c = t & 63;
    return (b << 13) + c * 128 + rw;
}
typedef const f32x4 (&AccRef)[2][2][4][2];
typedef unsigned gv4_t __attribute__((__vector_size__(16)));
#define BUF_RSRC(ptr) __builtin_amdgcn_make_buffer_rsrc((void*)(ptr), 0, 0x7fffffff, 0x00020000)
#define BUF_ST16(data, rsrc, voff, soff) __builtin_amdgcn_raw_buffer_store_b128(__builtin_bit_cast(gv4_t, (data)), (rsrc), (int)(voff), (int)(soff), 0)

struct EpiSwiglu {
    static constexpr bool PERM = true;
    bf16_t* HID;
    __device__ __forceinline__ void operator()(AccRef acc, const pg8::Unit& u, int wr, int wc, int fr, int fq) const {
        const __amdgpu_buffer_rsrc_t hr = BUF_RSRC(HID + (size_t)(u.pm * 256 + wr * 64) * HIDP + u.pn * 128 + wc * 32);
        const unsigned ho = (unsigned)(fr * HIDP + 8 * fq) * 2u;
#pragma unroll
        for (int ai = 0; ai < 2; ++ai)
#pragma unroll
            for (int m = 0; m < 4; ++m) {
                const f32x4 a0 = acc[ai][0][m][0], a1 = acc[ai][0][m][1], g0 = acc[ai][1][m][0], g1 = acc[ai][1][m][1];
                u32x4 w;
                w.x = pk2(siluf_(g0[0]) * a0[0], siluf_(g0[1]) * a0[1]); w.y = pk2(siluf_(g0[2]) * a0[2], siluf_(g0[3]) * a0[3]);
                w.z = pk2(siluf_(g1[0]) * a1[0], siluf_(g1[1]) * a1[1]); w.w = pk2(siluf_(g1[2]) * a1[2], siluf_(g1[3]) * a1[3]);
                BUF_ST16(w, hr, ho, (ai * 128 + m * 16) * HIDP * 2);
            }
    }
};
struct EpiResid {
    static constexpr bool PERM = true;
    bf16_t* H; const float* mod; float scale; int permute;
    __device__ __forceinline__ void operator()(AccRef acc, const pg8::Unit& u, int wr, int wc, int fr, int fq) const {
        const int row0 = u.pm * 256 + wr * 64 + fr, cw = u.pn * 256 + wc * 32 + 8 * fq;
        const float* mv = mod + (size_t)(u.pm < 64 ? (u.pm >> 5) : 2) * NADA;
        f32x4 mm[2][2];
#pragma unroll
        for (int bj = 0; bj < 2; ++bj)
#pragma unroll
            for (int n = 0; n < 2; ++n) mm[bj][n] = *(const f32x4*)(mv + cw + bj * 128 + 4 * n) * scale;
        u32x4 hh[4][2], w0[4][2];
#define ER_LOAD(ai) do { _Pragma("unroll") for (int m = 0; m < 4; ++m) { const int row = row0 + (ai) * 128 + m * 16; const int drow = permute ? seq2raster(row) : row; const bf16_t* hp = H + (size_t)drow * D + cw; \
            hh[m][0] = *(const u32x4*)hp; hh[m][1] = *(const u32x4*)(hp + 128); } } while (0)
#define ER_MATH(ai, dst) do { _Pragma("unroll") for (int m = 0; m < 4; ++m) _Pragma("unroll") for (int bj = 0; bj < 2; ++bj) { const u32x4 h_ = hh[m][bj]; const f32x4 v0 = mm[bj][0] * acc[ai][bj][m][0], v1 = mm[bj][1] * acc[ai][bj][m][1]; \
            dst[m][bj].x = pk2(bflo(h_.x) + v0[0], bfhi(h_.x) + v0[1]); dst[m][bj].y = pk2(bflo(h_.y) + v0[2], bfhi(h_.y) + v0[3]); dst[m][bj].z = pk2(bflo(h_.z) + v1[0], bfhi(h_.z) + v1[1]); dst[m][bj].w = pk2(bflo(h_.w) + v1[2], bfhi(h_.w) + v1[3]); } } while (0)
#define ER_STORE(ai, src) do { _Pragma("unroll") for (int m = 0; m < 4; ++m) { const int row = row0 + (ai) * 128 + m * 16; const int drow = permute ? seq2raster(row) : row; bf16_t* hp = H + (size_t)drow * D + cw; \
            *(u32x4*)hp = src[m][0]; *(u32x4*)(hp + 128) = src[m][1]; } } while (0)
        ER_LOAD(0);
        ER_MATH(0, w0);
        asm volatile("" ::: "memory");
        ER_LOAD(1);
        asm volatile("" ::: "memory");
        ER_STORE(0, w0);
        ER_MATH(1, w0);
        ER_STORE(1, w0);
#undef ER_LOAD
#undef ER_MATH
#undef ER_STORE
    }
};
struct EpiWin {
    static constexpr bool PERM = true;
    bf16_t* Z; bf16_t* G; float* GATES; bf16_t* KC; bf16_t* VC;
    __device__ __forceinline__ void operator()(AccRef acc, const pg8::Unit& u, int wr, int wc, int fr, int fq) const {
        const int row0 = u.pm * 256 + wr * 64 + fr, cw = wc * 32 + 8 * fq;
        if (u.pn < 32) {
            const __amdgpu_buffer_rsrc_t zr = BUF_RSRC(Z + (size_t)(u.pm * 256 + wr * 64) * ZW + u.pn * 256 + wc * 32); const unsigned zo = (unsigned)(fr * ZW + 8 * fq) * 2u;
#pragma unroll
            for (int ai = 0; ai < 2; ++ai)
#pragma unroll
                for (int m = 0; m < 4; ++m)
#pragma unroll
                    for (int bj = 0; bj < 2; ++bj) { const f32x4 v0 = acc[ai][bj][m][0], v1 = acc[ai][bj][m][1]; u32x4 w; w.x = pk2(v0[0], v0[1]); w.y = pk2(v0[2], v0[3]); w.z = pk2(v1[0], v1[1]); w.w = pk2(v1[2], v1[3]);
                        const int row = row0 + ai * 128 + m * 16, col = u.pn * 256 + bj * 128 + cw;
                        BUF_ST16(w, zr, zo, ((ai * 128 + m * 16) * ZW + bj * 128) * 2);
                        if (u.pn >= 22 && u.pn < 24) { const int kc = col - ZC_K; *(u32x4*)(KC + ((size_t)(kc >> 4) * MT + row) * 16 + (kc & 15)) = w; }
                        else if (u.pn >= 24 && u.pn < 28) { const int vc = col - ZC_V; *(u32x4*)(VC + ((size_t)(vc >> 4) * MT + row) * 16 + (vc & 15)) = w; } }
        } else if (u.pn < 96) {
            const __amdgpu_buffer_rsrc_t gr = BUF_RSRC(G + (size_t)(u.pm * 256 + wr * 64) * GW + (u.pn - 32) * 256 + wc * 32); const unsigned gof = (unsigned)(fr * GW + 8 * fq) * 2u;
#pragma unroll
            for (int ai = 0; ai < 2; ++ai)
#pragma unroll
                for (int m = 0; m < 4; ++m)
#pragma unroll
                    for (int bj = 0; bj < 2; ++bj) { const f32x4 v0 = acc[ai][bj][m][0], v1 = acc[ai][bj][m][1]; u32x4 w;
                        w.x = pk2(sigm(v0[0]), sigm(v0[1])); w.y = pk2(sigm(v0[2]), sigm(v0[3])); w.z = pk2(sigm(v1[0]), sigm(v1[1])); w.w = pk2(sigm(v1[2]), sigm(v1[3]));
                        BUF_ST16(w, gr, gof, ((ai * 128 + m * 16) * GW + bj * 128) * 2); }
        } else if (wc == 0 && fq < 2) {
#pragma unroll
            for (int ai = 0; ai < 2; ++ai)
#pragma unroll
                for (int m = 0; m < 4; ++m) { float* gp = GATES + (size_t)(row0 + ai * 128 + m * 16) * 16 + 8 * fq; *(f32x4*)gp = acc[ai][0][m][0]; *(f32x4*)(gp + 4) = acc[ai][0][m][1]; }
        }
    }
};
struct EpiGlu {
    static constexpr bool PERM = true;
    const bf16_t* GS5; bf16_t* BR; const float* bglu;
    __device__ __forceinline__ void operator()(AccRef acc, const pg8::Unit& u, int wr, int wc, int fr, int fq) const {
        const int row0 = u.pm * 256 + wr * 64 + fr, cw = u.pn * 256 + wc * 32 + 8 * fq;
#pragma unroll
        for (int bj = 0; bj < 2; ++bj) { const int col = cw + bj * 128; const f32x4 b0 = *(const f32x4*)(bglu + col), b1 = *(const f32x4*)(bglu + col + 4);
#pragma unroll
            for (int ai = 0; ai < 2; ++ai)
#pragma unroll
                for (int m = 0; m < 4; ++m) { const size_t row = (size_t)(row0 + ai * 128 + m * 16); const u32x4 g = *(const u32x4*)(GS5 + row * BW + col);
                    const f32x4 v0 = acc[ai][bj][m][0] + b0, v1 = acc[ai][bj][m][1] + b1; u32x4 w;
                    w.x = pk2(bflo(g.x) * sigm(v0[0]), bfhi(g.x) * sigm(v0[1])); w.y = pk2(bflo(g.y) * sigm(v0[2]), bfhi(g.y) * sigm(v0[3]));
                    w.z = pk2(bflo(g.z) * sigm(v1[0]), bfhi(g.z) * sigm(v1[1])); w.w = pk2(bflo(g.w) * sigm(v1[2]), bfhi(g.w) * sigm(v1[3]));
                    *(u32x4*)(BR + row * D + col) = w; asm volatile("" ::: "memory"); } }
    }
};
struct EpiPool {
    static constexpr bool PERM = true;
    bf16_t* BR; const float* scale;
    __device__ __forceinline__ void operator()(AccRef acc, const pg8::Unit& u, int wr, int wc, int fr, int fq) const {
        const int row0 = u.pm * 256 + wr * 64 + fr, cw = u.pn * 256 + wc * 32 + 8 * fq;
#pragma unroll
        for (int bj = 0; bj < 2; ++bj) { const int col = cw + bj * 128; const f32x4 s0 = *(const f32x4*)(scale + col), s1 = *(const f32x4*)(scale + col + 4);
#pragma unroll
            for (int ai = 0; ai < 2; ++ai)
#pragma unroll
                for (int m = 0; m < 4; ++m) { const size_t row = (size_t)(row0 + ai * 128 + m * 16); const f32x4 v0 = acc[ai][bj][m][0] * s0, v1 = acc[ai][bj][m][1] * s1; u32x4 w;
                    w.x = pk2(v0[0], v0[1]); w.y = pk2(v0[2], v0[3]); w.z = pk2(v1[0], v1[1]); w.w = pk2(v1[2], v1[3]);
                    *(u32x4*)(BR + row * D + 2048 + col) = w; } }
    }
};
struct EpiMerge2 {
    static constexpr bool PERM = true;
    const bf16_t* G; bf16_t* U; unsigned char* SCR;
    __device__ __forceinline__ void operator()(AccRef acc, const pg8::Unit& u, int wr, int wc, int fr, int fq) const {
        const unsigned char* gb = (const unsigned char*)(G + (size_t)(u.pm * 256 + wr * 64) * GW + u.kb * 4096 + u.pn * 256 + wc * 32);
        unsigned char* ub = (unsigned char*)(U + (size_t)(u.pm * 256 + wr * 64) * D + u.pn * 256 + wc * 32);
        unsigned char* sb = SCR + (wr * 4 + wc) * 1024;
        unsigned go = (unsigned)(fr * GW + 8 * fq) * 2u, uo = (unsigned)(fr * D + 8 * fq) * 2u, so = (unsigned)(fq * 16 + fr) * 16u;
        asm volatile("" : "+v"(go), "+v"(uo), "+v"(so));
        const bool rd = u.kb != 0, fin = u.kb == 3;
        u32x4 gg[4][2], ms[4][2];
#define EM_LOAD(ai) do { _Pragma("unroll") for (int m = 0; m < 4; ++m) _Pragma("unroll") for (int bj = 0; bj < 2; ++bj) { gg[m][bj] = *(const u32x4*)(gb + ((size_t)((ai) * 128 + m * 16) * GW + bj * 128) * 2 + go); \
            ms[m][bj] = rd ? *(const u32x4*)(sb + (((ai) * 4 + m) * 2 + bj) * 8192 + so) : (u32x4){0u, 0u, 0u, 0u}; } } while (0)
#define EM_MATH(ai, dst) do { _Pragma("unroll") for (int m = 0; m < 4; ++m) _Pragma("unroll") for (int bj = 0; bj < 2; ++bj) { const u32x4 g_ = gg[m][bj], s_ = ms[m][bj]; const f32x4 v0 = acc[ai][bj][m][0], v1 = acc[ai][bj][m][1]; u32x4 w_; \
            w_.x = pk2(bflo(s_.x) + bflo(g_.x) * v0[0], bfhi(s_.x) + bfhi(g_.x) * v0[1]); w_.y = pk2(bflo(s_.y) + bflo(g_.y) * v0[2], bfhi(s_.y) + bfhi(g_.y) * v0[3]); \
            w_.z = pk2(bflo(s_.z) + bflo(g_.z) * v1[0], bfhi(s_.z) + bfhi(g_.z) * v1[1]); w_.w = pk2(bflo(s_.w) + bflo(g_.w) * v1[2], bfhi(s_.w) + bfhi(g_.w) * v1[3]); dst[m][bj] = w_; } } while (0)
#define EM_STORE(ai, src) do { _Pragma("unroll") for (int m = 0; m < 4; ++m) _Pragma("unroll") for (int bj = 0; bj < 2; ++bj) { \
            if (fin) *(u32x4*)(ub + ((size_t)((ai) * 128 + m * 16) * D + bj * 128) * 2 + uo) = src[m][bj]; else *(u32x4*)(sb + (((ai) * 4 + m) * 2 + bj) * 8192 + so) = src[m][bj]; } } while (0)
        u32x4 w0[4][2];
        EM_LOAD(0);
        EM_MATH(0, w0);
#pragma unroll
        for (int m = 0; m < 4; ++m) asm volatile("" : "+v"(w0[m][0]), "+v"(w0[m][1]));
        asm volatile("" ::: "memory");
        EM_LOAD(1);
        asm volatile("" ::: "memory");
        EM_STORE(0, w0);
        EM_MATH(1, w0);
        EM_STORE(1, w0);
#undef EM_LOAD
#undef EM_MATH
#undef EM_STORE
    }
};

#define XB_TMO      128
#define XB_XCNT(j)  (256  + 64 * (j))
#define XB_XSUB(j)  (1280 + 64 * (j))
#define XB_XGEN(j)  (2304 + 64 * (j))
#define XB_TOP      3328
#define XB_TOPGEN   3392
#define XCD_BAR_WORDS 3456
#define XB_SPIN_CAP (1u << 20)
__device__ __forceinline__ unsigned xb_ld(unsigned* p)              { return __hip_atomic_load(p, __ATOMIC_RELAXED, __HIP_MEMORY_SCOPE_AGENT); }
__device__ __forceinline__ unsigned xb_add(unsigned* p, unsigned v) { return __hip_atomic_fetch_add(p, v, __ATOMIC_RELAXED, __HIP_MEMORY_SCOPE_AGENT); }
__device__ __forceinline__ unsigned xb_xcc_id() { return (unsigned)__builtin_amdgcn_s_getreg((3 << 11) | 20) & 0xFu; }
#define XB_SPIN(cond, bar) do { unsigned _sp = 0; while (cond) { __builtin_amdgcn_s_sleep(1); \
    if ((++_sp & 255u) == 0u) { if (xb_ld(&(bar)[XB_TMO])) break; if (_sp > XB_SPIN_CAP) { atomicAdd(&(bar)[XB_TMO], 1u); break; } } } } while (0)
struct XcdBarrier { unsigned* bar; unsigned x; volatile LAS unsigned* st; };
__device__ __forceinline__ XcdBarrier xcd_barrier_post(unsigned* bar, volatile LAS unsigned* st) {
    XcdBarrier b; b.bar = bar; b.x = xb_xcc_id(); b.st = st;
    if (threadIdx.x == 0) (void)xb_add(&bar[XB_XCNT(b.x)], 1u);
    return b;
}
__device__ __forceinline__ void xcd_barrier_complete(unsigned* bar, unsigned x, unsigned& nloc, unsigned& nx) {
    const unsigned G = gridDim.x * gridDim.y * gridDim.z;
    unsigned sum, cnt, mine, sp = 0u;
    for (;;) {
        sum = 0u; cnt = 0u; mine = 0u;
#pragma unroll
        for (unsigned j = 0; j < 16; ++j) { const unsigned c = xb_ld(&bar[XB_XCNT(j)]); sum += c; cnt += (c > 0u) ? 1u : 0u; mine = (j == x) ? c : mine; }
        if (sum == G) break;
        __builtin_amdgcn_s_sleep(1);
        if ((++sp & 255u) == 0u) { if (xb_ld(&bar[XB_TMO])) break; if (sp > XB_SPIN_CAP) { atomicAdd(&bar[XB_TMO], 1u); break; } }
    }
    nloc = mine > 0u ? mine : 1u; nx = cnt > 0u ? cnt : 1u;
}
__device__ __forceinline__ void xcd_barrier(const XcdBarrier& b) {
    asm volatile("s_waitcnt vmcnt(0)" ::: "memory");
    __syncthreads();
    if (threadIdx.x == 0) {
        unsigned* bar = b.bar;
        __builtin_amdgcn_s_waitcnt(0);
        unsigned nloc = b.st[0], nx = b.st[1];
        if (nloc == 0u) { xcd_barrier_complete(bar, b.x, nloc, nx); b.st[0] = nloc; b.st[1] = nx; }
        const unsigned old = xb_add(&bar[XB_XSUB(b.x)], 1u);
        const unsigned gen = old / nloc;
        if (old + 1u == (gen + 1u) * nloc) {
            __builtin_amdgcn_fence(__ATOMIC_RELEASE, "agent");
            asm volatile("s_waitcnt vmcnt(0)" ::: "memory");
            const unsigned og = xb_add(&bar[XB_TOP], 1u);
            const unsigned tg = og / nx;
            if (og + 1u == (tg + 1u) * nx) xb_add(&bar[XB_TOPGEN], 1u);
            else XB_SPIN(xb_ld(&bar[XB_TOPGEN]) == tg, bar);
            __builtin_amdgcn_fence(__ATOMIC_ACQUIRE, "agent");
            xb_add(&bar[XB_XGEN(b.x)], 1u);
            asm volatile("s_waitcnt vmcnt(0)" ::: "memory");
        } else {
            XB_SPIN(xb_ld(&bar[XB_XGEN(b.x)]) == gen, bar);
            __builtin_amdgcn_fence(__ATOMIC_ACQUIRE, "agent");
            asm volatile("s_waitcnt vmcnt(0)" ::: "memory");
        }
    }
    __syncthreads();
}

constexpr int NWAVES = 8, NTHR = 512;
constexpr int LDS_BYTES = 155648;
constexpr int MISC_OFF = LDS_BYTES - 256;
constexpr int NPH = 29;

struct Args { const float* in[29]; float* out; unsigned char* ws; int ph_lo, ph_hi, use_bar, pad; };
enum { I_X = 0, I_C, I_CTX, I_CCTX, I_WADA, I_BADA, I_F1IN, I_F1OUT, I_F2IN, I_F2OUT, I_WIN, I_S5ARE, I_S5AIM, I_S5DT, I_S5BRE, I_S5BIM, I_S5CRE, I_S5CIM, I_S5D, I_S5WGLU, I_S5BGLU,
       I_CONVW, I_POOLW, I_POOLS, I_MGB, I_MNG, I_WBR, I_WOUT, I_FG };

struct Frame {
    LAS unsigned char* lds;
    int tid, lane, wave, G, gw, NGW;
    unsigned char* ws;
};

constexpr int ADA_KC = 16, ADA_NC = NADA / 256, ADA_ITEMS = NL * ADA_KC * ADA_NC;
__device__ __forceinline__ void p0_ada_item(const Frame& F, const Args& a, int it) {
    const int l = it / (ADA_KC * ADA_NC), r = it % (ADA_KC * ADA_NC), kc = r / ADA_NC, nc = r % ADA_NC, k0 = kc * (D / ADA_KC), col = nc * 256 + 4 * F.lane;
    const float* W = a.in[I_WADA] + ((size_t)l * D + k0) * NADA + col;
    f32x4 a0 = {0.f, 0.f, 0.f, 0.f}, a1 = a0, a2 = a0;
#pragma unroll 1
    for (int j = 0; j < 4; ++j) {
        const int k = k0 + 64 * j + F.lane;
        const float x0 = a.in[I_C][k], x1 = a.in[I_C][D + k], x2 = a.in[I_CCTX][k];
        const float s0 = x0 / (1.f + expf(-x0)), s1 = x1 / (1.f + expf(-x1)), s2 = x2 / (1.f + expf(-x2));
#pragma unroll
        for (int kb = 0; kb < 64; kb += 16) {
            f32x4 w[16];
#pragma unroll
            for (int u = 0; u < 16; ++u) w[u] = __builtin_nontemporal_load((const f32x4*)(W + (size_t)(64 * j + kb + u) * NADA));
#pragma unroll
            for (int u = 0; u < 16; ++u) { const float b0 = __int_as_float(__builtin_amdgcn_readlane(__float_as_int(s0), kb + u)), b1 = __int_as_float(__builtin_amdgcn_readlane(__float_as_int(s1), kb + u)), b2 = __int_as_float(__builtin_amdgcn_readlane(__float_as_int(s2), kb + u));
                a0 += w[u] * b0; a1 += w[u] * b1; a2 += w[u] * b2; }
        }
    }
    float* P = (float*)(F.ws + WS_ADAP) + (((size_t)l * ADA_KC + kc) * 3) * NADA + col;
    *(f32x4*)P = a0; *(f32x4*)(P + NADA) = a1; *(f32x4*)(P + 2 * NADA) = a2;
}
__device__ __forceinline__ void p0_ada_reduce(const Frame& F, const Args& a, int l0, int l1) {
    float* MOD = (float*)(F.ws + WS_MOD); const float* P = (const float*)(F.ws + WS_ADAP);
    for (int i = l0 * 3 * (NADA / 4) + blockIdx.x * NTHR + F.tid; i < l1 * 3 * (NADA / 4); i += F.G * NTHR) {
        const int l = i / (3 * (NADA / 4)), r = i % (3 * (NADA / 4)), v = r / (NADA / 4), c4 = (r % (NADA / 4)) * 4;
        f32x4 s = *(const f32x4*)(a.in[I_BADA] + (size_t)l * NADA + c4);
#pragma unroll
        for (int kc = 0; kc < ADA_KC; ++kc) s += *(const f32x4*)(P + (((size_t)l * ADA_KC + kc) * 3 + v) * NADA + c4);
        *(f32x4*)(MOD + ((size_t)l * 3 + v) * NADA + c4) = s;
    }
}

__device__ __forceinline__ int dst_row(int n, int mode) {
    if (mode == 1) { const int half = n >= DFF ? 1 : 0, jj = n - half * DFF; return 256 * (jj >> 7) + 128 * half + (jj & 127); }
    if (mode == 2) { return n < ZW ? n : (n < ZW + 16 ? (ZW + GW) + (n - ZW) : n - 16); }
    return n;
}
__device__ __forceinline__ void p0_transpose_item(const float* W, int K, int N, bf16_t* WT, int ldd, int mode, LAS unsigned* Lt, int item, int lane) {
    const int nblk = (N + 127) / 128, kb = item / nblk, nb = item % nblk, k0 = 64 * kb, n0 = 128 * nb;
    const int hl = lane >> 5, ln = lane & 31, ncol = n0 + 4 * ln; const bool ok = ncol < N;
#pragma unroll
    for (int hf = 0; hf < 2; ++hf) {
        f32x4 r0[8], r1[8];
#pragma unroll
        for (int i = 0; i < 8; ++i) { const int pp = 2 * (hf * 8 + i) + hl; const float* p = W + (size_t)(k0 + 2 * pp) * N + ncol;
            r0[i] = ok ? __builtin_nontemporal_load((const f32x4*)p) : (f32x4){0.f, 0.f, 0.f, 0.f}; r1[i] = ok ? __builtin_nontemporal_load((const f32x4*)(p + N)) : (f32x4){0.f, 0.f, 0.f, 0.f}; }
#pragma unroll
        for (int i = 0; i < 8; ++i) { const int pp = 2 * (hf * 8 + i) + hl;
#pragma unroll
            for (int e = 0; e < 4; ++e) Lt[(4 * ln + e) * 33 + pp] = pk2(r0[i][e], r1[i][e]); }
    }
    LDS_WAIT();
#pragma unroll 4
    for (int j = 0; j < 16; ++j) { const int q = j * 64 + lane, nrow = q >> 3, kc = q & 7; const LAS unsigned* s = Lt + nrow * 33 + 4 * kc;
        u32x4 o; o.x = s[0]; o.y = s[1]; o.z = s[2]; o.w = s[3];
        if (n0 + nrow < N) __builtin_nontemporal_store(o, (u32x4*)(WT + (size_t)dst_row(n0 + nrow, mode) * ldd + k0 + 8 * kc)); }
    LDS_WAIT();
}
constexpr int I_FIN = (D / 64) * (2 * DFF / 128), I_FOUT = (DFF / 64) * (D / 128), I_IN = (D / 64) * ((NIN + 127) / 128), I_GLU = (BW / 64) * (BW / 128),
              I_PW = (256 / 64) * (256 / 128), I_BRI = (BW / 64) * (D / 128), I_OUT = (D / 64) * (D / 128);
constexpr int PER_L = 2 * I_FIN + 2 * I_FOUT + I_IN + I_GLU + 4 * I_PW + 4 * I_BRI + I_OUT;
__device__ __forceinline__ void p0_tr_item(const Frame& F, const Args& a, int l, int r, LAS unsigned* Lt) {
    if (r < I_FIN) { p0_transpose_item(a.in[I_F1IN] + (size_t)l * D * 2 * DFF, D, 2 * DFF, (bf16_t*)(F.ws + WS_W1IN + (size_t)(l * 2 + 0) * SZ_WFIN), D, 1, Lt, r, F.lane); return; } r -= I_FIN;
    if (r < I_FIN) { p0_transpose_item(a.in[I_F2IN] + (size_t)l * D * 2 * DFF, D, 2 * DFF, (bf16_t*)(F.ws + WS_W1IN + (size_t)(l * 2 + 1) * SZ_WFIN), D, 1, Lt, r, F.lane); return; } r -= I_FIN;
    if (r < I_FOUT) { p0_transpose_item(a.in[I_F1OUT] + (size_t)l * DFF * D, DFF, D, (bf16_t*)(F.ws + WS_W1OUT + (size_t)(l * 2 + 0) * SZ_WFOUT), DFF, 0, Lt, r, F.lane); return; } r -= I_FOUT;
    if (r < I_FOUT) { p0_transpose_item(a.in[I_F2OUT] + (size_t)l * DFF * D, DFF, D, (bf16_t*)(F.ws + WS_W1OUT + (size_t)(l * 2 + 1) * SZ_WFOUT), DFF, 0, Lt, r, F.lane); return; } r -= I_FOUT;
    if (r < I_IN) { p0_transpose_item(a.in[I_WIN] + (size_t)l * D * NIN, D, NIN, (bf16_t*)(F.ws + WS_WIN + (size_t)l * SZ_WIN), D, 2, Lt, r, F.lane); return; } r -= I_IN;
    if (r < I_GLU) { p0_transpose_item(a.in[I_S5WGLU] + (size_t)l * BW * BW, BW, BW, (bf16_t*)(F.ws + WS_WGLU + (size_t)l * SZ_WGLU), BW, 0, Lt, r, F.lane); return; } r -= I_GLU;
    if (r < 4 * I_PW) { const int gi = r / I_PW; p0_transpose_item(a.in[I_POOLW] + ((size_t)l * 4 + gi) * 256 * 256, 256, 256, (bf16_t*)(F.ws + WS_WPOOL + (size_t)l * SZ_WPOOL) + (size_t)gi * 256 * 256, 256, 0, Lt, r % I_PW, F.lane); return; } r -= 4 * I_PW;
    if (r < 4 * I_BRI) { const int bi = r / I_BRI; p0_transpose_item(a.in[I_WBR] + ((size_t)l * 4 + bi) * BW * D, BW, D, (bf16_t*)(F.ws + WS_WBR + (size_t)l * SZ_WSQ) + bi * BW, D, 0, Lt, r % I_BRI, F.lane); return; } r -= 4 * I_BRI;
    p0_transpose_item(a.in[I_WOUT] + (size_t)l * D * D, D, D, (bf16_t*)(F.ws + WS_WOUT + (size_t)l * SZ_WSQ), D, 0, Lt, r, F.lane);
}
constexpr int DEF_L0 = 13312, DEF_TOTAL = DEF_L0 + PER_L, DEF_TAILS = 47040;
__device__ __forceinline__ void deferred_item(const Frame& F, const Args& a, int v, LAS unsigned* Lt) {
    if (v < 2048) { p0_tr_item(F, a, 0, 30944 + v, Lt); return; }
    if (v < 4096) { p0_tr_item(F, a, 0, 32992 + (v - 2048), Lt); return; }
    if (v < 10240) { p0_tr_item(F, a, 0, 6144 + (v - 4096), Lt); return; }
    if (v < DEF_L0) { p0_tr_item(F, a, 0, 15360 + (v - 10240), Lt); return; }
    const int w = v - DEF_L0;
    if (w < 18432) { p0_tr_item(F, a, 1, w, Lt); return; }
    if (w < 22688) { p0_tr_item(F, a, 1, 30784 + (w - 18432), Lt); return; }
    p0_tr_item(F, a, 1, 18432 + (w - 22688), Lt);
}
constexpr int P0_EARLY = 6144 + 3072 + 12512;
constexpr int ADA_L = ADA_ITEMS / NL, SLOT_ITEMS = ADA_L + 3072 + 12512;
__device__ __forceinline__ void p0_transposes(const Frame& F, const Args& a) {
    LAS unsigned* Lt = (LAS unsigned*)(F.lds + F.wave * (128 * 33 * 4));
    for (int it0 = F.gw; it0 < ADA_L + 6144 + (DEF_TOTAL - DEF_TAILS); it0 += F.NGW) {
        if (it0 < ADA_L) { p0_ada_item(F, a, it0); continue; }
        const int j = it0 - ADA_L;
        if (j < 6144) p0_tr_item(F, a, 0, j, Lt);
        else deferred_item(F, a, DEF_TAILS + (j - 6144), Lt);
    }
    for (int l = 0; l < NL; ++l) { u32x4* p = (u32x4*)((bf16_t*)(F.ws + WS_WIN + (size_t)l * SZ_WIN) + (size_t)NIN * D); const int n16 = (NINP - NIN) * D / 8;
        for (int i = blockIdx.x * NTHR + F.tid; i < n16; i += F.G * NTHR) p[i] = (u32x4){0u, 0u, 0u, 0u}; }
}
__device__ __forceinline__ void slot_items(const Frame& F, const Args& a) {
    LAS unsigned* Lt = (LAS unsigned*)(F.lds + F.wave * (128 * 33 * 4));
    for (int s = F.gw; s < SLOT_ITEMS; s += F.NGW) {
        if (s < ADA_L) { p0_ada_item(F, a, ADA_L + s); continue; }
        const int j = s - ADA_L;
        if (j < 3072) p0_tr_item(F, a, 0, 12288 + j, Lt);
        else p0_tr_item(F, a, 0, 18432 + (j - 3072), Lt);
    }
}

__device__ __forceinline__ void tail_items(const Frame& F, const Args& a, int nwg, int lo, int hi) {
    const int r = nwg % F.G; const int c = (int)blockIdx.x;
    if (r == 0 || c < r) return;
    LAS unsigned* Lt = (LAS unsigned*)(F.lds + F.wave * (128 * 33 * 4));
    const int nidle = (F.G - r) * NWAVES;
    for (int it = lo + (c - r) * NWAVES + F.wave; it < hi; it += nidle) deferred_item(F, a, it, Lt);
}

__device__ __forceinline__ void ctx_gates(const Frame& F, int l) {
    if (F.gw >= MC / 16) return;
    const bf16_t* U = (const bf16_t*)(F.ws + WS_U); const bf16_t* Wg = (const bf16_t*)(F.ws + WS_WIN + (size_t)l * SZ_WIN) + (size_t)(ZW + GW) * D; float* GATES = (float*)(F.ws + WS_GATES);
    const int c16 = F.lane & 15, q = F.lane >> 4, row0 = ML + 16 * F.gw;
    const bf16_t* ap = U + (size_t)(row0 + c16) * D + 8 * q; const bf16_t* bp = Wg + (size_t)c16 * D + 8 * q;
    f32x4 acc = {0.f, 0.f, 0.f, 0.f};
#pragma unroll 8
    for (int k = 0; k < D; k += 32) { const bf16x8 af = __builtin_bit_cast(bf16x8, *(const u32x4*)(ap + k)), bf = __builtin_bit_cast(bf16x8, *(const u32x4*)(bp + k));
        acc = __builtin_amdgcn_mfma_f32_16x16x32_bf16(af, bf, acc, 0, 0, 0); }
#pragma unroll
    for (int i = 0; i < 4; ++i) GATES[(size_t)(row0 + 4 * q + i) * 16 + c16] = acc[i];
}

__device__ __forceinline__ void norm_phase(const Frame& F, const Args& a, int l, int si, int nrows, bool first, bool permute) {
    bf16_t* H = (bf16_t*)(F.ws + WS_H); bf16_t* U = (bf16_t*)(F.ws + WS_U);
    const float* MODL = (const float*)(F.ws + WS_MOD) + (size_t)l * 3 * NADA;
    for (int row = F.gw; row < nrows; row += F.NGW) {
        f32x4 v[16]; float ss = 0.f;
        if (first) {
            const f32x4* xr = (const f32x4*)(row < ML ? a.in[I_X] + (size_t)row * D : a.in[I_CTX] + (size_t)(row - ML) * D) + F.lane;
#pragma unroll
            for (int j = 0; j < 16; ++j) v[j] = xr[64 * j];
            u32x2* hw = (u32x2*)(H + (size_t)row * D) + F.lane;
#pragma unroll
            for (int j = 0; j < 16; ++j) { u32x2 w; w.x = pk2(v[j][0], v[j][1]); w.y = pk2(v[j][2], v[j][3]); hw[64 * j] = w; }
        } else {
            const u32x2* hr = (const u32x2*)(H + (size_t)row * D) + F.lane;
#pragma unroll
            for (int j = 0; j < 16; ++j) { const u32x2 w = hr[64 * j]; v[j] = (f32x4){bflo(w.x), bfhi(w.x), bflo(w.y), bfhi(w.y)}; }
        }
#pragma unroll
        for (int j = 0; j < 16; ++j) ss += (v[j][0] * v[j][0] + v[j][1] * v[j][1]) + (v[j][2] * v[j][2] + v[j][3] * v[j][3]);
        const float rstd = 1.f / sqrtf(wave_sum(ss) * (1.f / D) + EPS);
        const float* mv = MODL + (size_t)(row < ML ? (row >> 13) : 2) * NADA;
        const f32x4* sh = (const f32x4*)(mv + (size_t)si * D) + F.lane; const f32x4* sc = (const f32x4*)(mv + (size_t)(si + 1) * D) + F.lane;
        const int orow = permute ? raster2seq(row) : row;
        u32x2* o8 = (u32x2*)(U + (size_t)orow * D) + F.lane;
#pragma unroll
        for (int j = 0; j < 16; ++j) { const f32x4 s = sh[64 * j], c = sc[64 * j]; const f32x4 y = v[j] * rstd * (c + 1.f) + s; u32x2 w; w.x = pk2(y[0], y[1]); w.y = pk2(y[2], y[3]); o8[64 * j] = w; }
    }
}
__device__ __forceinline__ void final_norm_phase(const Frame& F, const Args& a) {
    const bf16_t* H = (const bf16_t*)(F.ws + WS_H);
    for (int row = F.gw; row < ML; row += F.NGW) {
        const u32x2* hr = (const u32x2*)(H + (size_t)row * D) + F.lane; const f32x4* fg = (const f32x4*)a.in[I_FG] + F.lane;
        f32x4 v[16]; float ss = 0.f;
#pragma unroll
        for (int j = 0; j < 16; ++j) { const u32x2 w = hr[64 * j]; v[j] = (f32x4){bflo(w.x), bfhi(w.x), bflo(w.y), bfhi(w.y)}; ss += (v[j][0] * v[j][0] + v[j][1] * v[j][1]) + (v[j][2] * v[j][2] + v[j][3] * v[j][3]); }
        const float rstd = 1.f / sqrtf(wave_sum(ss) * (1.f / D) + EPS);
        f32x4* o = (f32x4*)(a.out + (size_t)row * D) + F.lane;
#pragma unroll
        for (int j = 0; j < 16; ++j) o[64 * j] = v[j] * rstd * fg[64 * j];
    }
}

typedef float f32x16 __attribute__((ext_vector_type(16)));
constexpr int S5_NSEG = 16, S5_SL = (T + CT) / S5_NSEG, S5_NBAT = S5_SL / 16;
constexpr int S5_XPB = 272;
__device__ __forceinline__ int s5_row(int p, int b, int dir) {
    if (p < CT) return ML + b * CT + (dir ? (CT - 1 - p) : p);
    const int q = p - CT; return b * T + (dir ? (T - 1 - q) : q);
}
__device__ __forceinline__ void s5_scan_phase(const Frame& F, const Args& a, int l) {
    const bf16_t* Z = (const bf16_t*)(F.ws + WS_Z); float* YP = (float*)(F.ws + WS_YP);
    LAS float* Es = (LAS float*)F.lds;
    LAS unsigned char* Xl = F.lds + 8192 + F.wave * (32 * S5_XPB);
    const int lane = F.lane, n = lane & 31, h = lane >> 5, w = F.wave;
    for (int unit = blockIdx.x; unit < NB * S5G * 2; unit += F.G) {
        const int b = unit >> 7, g = (unit >> 1) & 63, dir = unit & 1;
        const size_t pb = (((size_t)l * 2 + dir) * S5G + g);
        const float dt = expf(a.in[I_S5DT][pb]);
        float lre[2], lim[2], Lr[2], Li[2]; bf16x8 Bf[4];
#pragma unroll
        for (int e = 0; e < 2; ++e) {
            const int st = n + 32 * e;
            const float are = a.in[I_S5ARE][pb * S5N + st], aim = a.in[I_S5AIM][pb * S5N + st];
            const float mag = expf(dt * are); lre[e] = mag * cosf(dt * aim); lim[e] = mag * sinf(dt * aim);
            const float den = are * are + aim * aim;
            const float zre = ((lre[e] - 1.f) * are + lim[e] * aim) / den, zim = (lim[e] * are - (lre[e] - 1.f) * aim) / den;
            float br[8], bi[8];
#pragma unroll
            for (int c = 0; c < 8; ++c) { const float x = a.in[I_S5BRE][(pb * S5N + st) * S5P + 8 * h + c], y = a.in[I_S5BIM][(pb * S5N + st) * S5P + 8 * h + c]; br[c] = zre * x - zim * y; bi[c] = zre * y + zim * x; }
            u32x4 pr, pi; pr.x = pk2(br[0], br[1]); pr.y = pk2(br[2], br[3]); pr.z = pk2(br[4], br[5]); pr.w = pk2(br[6], br[7]); pi.x = pk2(bi[0], bi[1]); pi.y = pk2(bi[2], bi[3]); pi.z = pk2(bi[4], bi[5]); pi.w = pk2(bi[6], bi[7]);
            Bf[e] = __builtin_bit_cast(bf16x8, pr); Bf[2 + e] = __builtin_bit_cast(bf16x8, pi);
            float pr_ = lre[e], pi_ = lim[e], q16r = 0.f, q16i = 0.f;
#pragma unroll
            for (int s = 0; s < 9; ++s) { const float t = pr_ * pr_ - pi_ * pi_; pi_ = 2.f * pr_ * pi_; pr_ = t; if (s == 3) { q16r = pr_; q16i = pi_; } }
            Lr[e] = pr_ * q16r - pi_ * q16i; Li[e] = pr_ * q16i + pi_ * q16r;
        }
        bf16x8 Cf[4];
        { const int ch = lane & 15, q = lane >> 4;
#pragma unroll
          for (int s = 0; s < 4; ++s) { float cv[8];
#pragma unroll
              for (int c = 0; c < 8; ++c) { const int k = 32 * s + 8 * q + c, np = k >> 2, cc = k & 3, st = np + 32 * (cc & 1);
                  cv[c] = (cc >> 1) ? -a.in[I_S5CIM][(pb * S5P + ch) * S5N + st] : a.in[I_S5CRE][(pb * S5P + ch) * S5N + st]; }
              u32x4 p; p.x = pk2(cv[0], cv[1]); p.y = pk2(cv[2], cv[3]); p.z = pk2(cv[4], cv[5]); p.w = pk2(cv[6], cv[7]); Cf[s] = __builtin_bit_cast(bf16x8, p); } }
        const int r = lane & 31, hr = (r >> 2) & 1, ir = (r & 3) + 4 * (r >> 3);
        const int pa0 = (2 * w + hr) * S5_SL + ir;
        const bf16_t* zcol = Z + ZC_S5 + g * 16 + 8 * h;
        const int seg = 2 * w + h;
        float x0r = 0.f, x0i = 0.f, x1r = 0.f, x1i = 0.f;
        for (int pass = 0; pass < 2; ++pass) {
            if (pass == 1) {
                __syncthreads();
                *(LAS f32x2*)(Es + (seg * 64 + n) * 2) = (f32x2){x0r, x0i}; *(LAS f32x2*)(Es + (seg * 64 + n + 32) * 2) = (f32x2){x1r, x1i};
                __syncthreads();
                float c0r = 0.f, c0i = 0.f, c1r = 0.f, c1i = 0.f;
                for (int s = 0; s < seg; ++s) { const f32x2 e0 = *(const LAS f32x2*)(Es + (s * 64 + n) * 2), e1 = *(const LAS f32x2*)(Es + (s * 64 + n + 32) * 2);
                    float t = Lr[0] * c0r - Li[0] * c0i + e0[0]; c0i = Lr[0] * c0i + Li[0] * c0r + e0[1]; c0r = t;
                    t = Lr[1] * c1r - Li[1] * c1i + e1[0]; c1i = Lr[1] * c1i + Li[1] * c1r + e1[1]; c1r = t; }
                x0r = c0r; x0i = c0i; x1r = c1r; x1i = c1i;
            }
            u32x4 uq[3];
#pragma unroll
            for (int u = 0; u < 3; ++u) uq[u] = *(const u32x4*)(zcol + (size_t)s5_row(pa0 + 16 * u, b, dir) * ZW);
            for (int bt0 = 0; bt0 < S5_NBAT; bt0 += 3)
#pragma unroll
            for (int u = 0; u < 3; ++u) {
                const int bt = bt0 + u;
                const bf16x8 Af = __builtin_bit_cast(bf16x8, uq[u]);
                if (bt + 3 < S5_NBAT) uq[u] = *(const u32x4*)(zcol + (size_t)s5_row(pa0 + 16 * (bt + 3), b, dir) * ZW);
                f32x16 zero;
#pragma unroll
                for (int i = 0; i < 16; ++i) zero[i] = 0.f;
                const f32x16 a0 = __builtin_amdgcn_mfma_f32_32x32x16_bf16(Af, Bf[0], zero, 0, 0, 0), a1 = __builtin_amdgcn_mfma_f32_32x32x16_bf16(Af, Bf[1], zero, 0, 0, 0);
                const f32x16 a2 = __builtin_amdgcn_mfma_f32_32x32x16_bf16(Af, Bf[2], zero, 0, 0, 0), a3 = __builtin_amdgcn_mfma_f32_32x32x16_bf16(Af, Bf[3], zero, 0, 0, 0);
#pragma unroll
                for (int i = 0; i < 16; ++i) {
                    float t = lre[0] * x0r - lim[0] * x0i + a0[i]; x0i = lre[0] * x0i + lim[0] * x0r + a2[i]; x0r = t;
                    t = lre[1] * x1r - lim[1] * x1i + a1[i]; x1i = lre[1] * x1i + lim[1] * x1r + a3[i]; x1r = t;
                    if (pass == 1) { u32x2 wv; wv.x = pk2(x0r, x1r); wv.y = pk2(x0i, x1i); *(LAS u32x2*)(Xl + (16 * h + i) * S5_XPB + 8 * n) = wv; }
                }
                if (pass == 1) {
                    LDS_WAIT();
#pragma unroll
                    for (int gq = 0; gq < 2; ++gq) {
                        f32x4 d = {0.f, 0.f, 0.f, 0.f};
#pragma unroll
                        for (int s = 0; s < 4; ++s) { const bf16x8 Xf = *(const LAS bf16x8*)(Xl + (16 * gq + (lane & 15)) * S5_XPB + 64 * s + 16 * (lane >> 4)); d = __builtin_amdgcn_mfma_f32_16x16x32_bf16(Cf[s], Xf, d, 0, 0, 0); }
                        const int p = (2 * w + gq) * S5_SL + 16 * bt + (lane & 15);
                        *(f32x4*)(YP + ((size_t)dir * MT + s5_row(p, b, dir)) * BW + g * 16 + 4 * (lane >> 4)) = d;
                    }
                    LDS_WAIT();
                }
            }
        }
    }
    __syncthreads();
}
__device__ __forceinline__ void s5_combine_phase(const Frame& F, const Args& a, int l, int nrows) {
    const bf16_t* Z = (const bf16_t*)(F.ws + WS_Z); const float* YP = (const float*)(F.ws + WS_YP); bf16_t* GS5 = (bf16_t*)(F.ws + WS_GS5);
    const float* dsk = a.in[I_S5D] + (size_t)l * BW;
    const int total = nrows * (BW / 8);
    const int stride = F.G * NTHR; int i = blockIdx.x * NTHR + F.tid;
    if (i >= total) return;
    const int c = (i & 127) * 8;
    const f32x4 d0 = *(const f32x4*)(dsk + c), d1 = *(const f32x4*)(dsk + c + 4);
    u32x4 u = *(const u32x4*)(Z + (size_t)(i >> 7) * ZW + ZC_S5 + c);
    f32x4 ya0 = *(const f32x4*)(YP + (size_t)(i >> 7) * BW + c), ya1 = *(const f32x4*)(YP + (size_t)(i >> 7) * BW + c + 4);
    f32x4 yb0 = *(const f32x4*)(YP + (size_t)(MT + (i >> 7)) * BW + c), yb1 = *(const f32x4*)(YP + (size_t)(MT + (i >> 7)) * BW + c + 4);
    for (; i < total; i += stride) {
        const int row = i >> 7, rn = (i + stride < total ? i + stride : i) >> 7;
        const u32x4 un = *(const u32x4*)(Z + (size_t)rn * ZW + ZC_S5 + c);
        const f32x4 na0 = *(const f32x4*)(YP + (size_t)rn * BW + c), na1 = *(const f32x4*)(YP + (size_t)rn * BW + c + 4);
        const f32x4 nb0 = *(const f32x4*)(YP + (size_t)(MT + rn) * BW + c), nb1 = *(const f32x4*)(YP + (size_t)(MT + rn) * BW + c + 4);
        asm volatile("" ::: "memory");
        f32x4 y0, y1;
        y0[0] = d0[0] * bflo(u.x) + ya0[0] + yb0[0]; y0[1] = d0[1] * bfhi(u.x) + ya0[1] + yb0[1]; y0[2] = d0[2] * bflo(u.y) + ya0[2] + yb0[2]; y0[3] = d0[3] * bfhi(u.y) + ya0[3] + yb0[3];
        y1[0] = d1[0] * bflo(u.z) + ya1[0] + yb1[0]; y1[1] = d1[1] * bfhi(u.z) + ya1[1] + yb1[1]; y1[2] = d1[2] * bflo(u.w) + ya1[2] + yb1[2]; y1[3] = d1[3] * bfhi(u.w) + ya1[3] + yb1[3];
        u32x4 w; w.x = pk2(gelu_tanh(y0[0]), gelu_tanh(y0[1])); w.y = pk2(gelu_tanh(y0[2]), gelu_tanh(y0[3])); w.z = pk2(gelu_tanh(y1[0]), gelu_tanh(y1[1])); w.w = pk2(gelu_tanh(y1[2]), gelu_tanh(y1[3]));
        *(u32x4*)(GS5 + (size_t)row * BW + c) = w;
        u = un; ya0 = na0; ya1 = na1; yb0 = nb0; yb1 = nb1;
    }
}

__device__ __forceinline__ void seq_bounds(int row, int& lo, int& hi) { if (row < ML) { lo = row & ~(T - 1); hi = lo + T; } else { lo = ML + ((row - ML) & ~(CT - 1)); hi = lo + CT; } }
template <int HW>
__device__ __forceinline__ void conv_pool_item(const bf16_t* Z, bf16_t* BR, bf16_t* PL, const float* cw, int row, int c, int lo, int hi) {
    u32x4 hh[3], cc[3], uu[2 * HW];
#pragma unroll
    for (int j = 0; j < 3; ++j) { const int r = row - 1 + j; const bool ok = (r >= lo && r < hi);
        hh[j] = ok ? *(const u32x4*)(Z + (size_t)r * ZW + ZC_CH + c) : (u32x4){0u, 0u, 0u, 0u}; cc[j] = ok ? *(const u32x4*)(Z + (size_t)r * ZW + ZC_CC + c) : (u32x4){0u, 0u, 0u, 0u}; }
    const u32x4 bg = *(const u32x4*)(Z + (size_t)row * ZW + ZC_CB + c);
#pragma unroll
    for (int k = 0; k < 2 * HW; ++k) { const int r = row - HW + k; const bool ok = (r >= lo && r < hi);
        uu[k] = ok ? *(const u32x4*)(Z + (size_t)r * ZW + ZC_PL + c) : (u32x4){0u, 0u, 0u, 0u}; }
    asm volatile("" ::: "memory");
    float y[8];
#pragma unroll
    for (int e = 0; e < 8; ++e) y[e] = 0.f;
#pragma unroll
    for (int j = 0; j < 3; ++j) { const f32x4 w0 = *(const f32x4*)(cw + j * BW + c), w1 = *(const f32x4*)(cw + j * BW + c + 4);
        y[0] += w0[0] * bflo(hh[j].x) * bflo(cc[j].x); y[1] += w0[1] * bfhi(hh[j].x) * bfhi(cc[j].x); y[2] += w0[2] * bflo(hh[j].y) * bflo(cc[j].y); y[3] += w0[3] * bfhi(hh[j].y) * bfhi(cc[j].y);
        y[4] += w1[0] * bflo(hh[j].z) * bflo(cc[j].z); y[5] += w1[1] * bfhi(hh[j].z) * bfhi(cc[j].z); y[6] += w1[2] * bflo(hh[j].w) * bflo(cc[j].w); y[7] += w1[3] * bfhi(hh[j].w) * bfhi(cc[j].w); }
    { u32x4 w;
      w.x = pk2(y[0] * bflo(bg.x), y[1] * bfhi(bg.x)); w.y = pk2(y[2] * bflo(bg.y), y[3] * bfhi(bg.y)); w.z = pk2(y[4] * bflo(bg.z), y[5] * bfhi(bg.z)); w.w = pk2(y[6] * bflo(bg.w), y[7] * bfhi(bg.w));
      *(u32x4*)(BR + (size_t)row * D + 1024 + c) = w; }
    float s[8];
#pragma unroll
    for (int e = 0; e < 8; ++e) s[e] = 0.f;
#pragma unroll
    for (int k = 0; k < 2 * HW; ++k) { s[0] += bflo(uu[k].x); s[1] += bfhi(uu[k].x); s[2] += bflo(uu[k].y); s[3] += bfhi(uu[k].y); s[4] += bflo(uu[k].z); s[5] += bfhi(uu[k].z); s[6] += bflo(uu[k].w); s[7] += bfhi(uu[k].w); }
    const int r0 = (row - HW) < lo ? lo : row - HW, r1 = (row + HW) > hi ? hi : row + HW;
    const float inv = 1.f / (float)(r1 - r0); const u32x4 us = uu[HW]; u32x4 w;
    w.x = pk2(s[0] * inv - bflo(us.x), s[1] * inv - bfhi(us.x)); w.y = pk2(s[2] * inv - bflo(us.y), s[3] * inv - bfhi(us.y));
    w.z = pk2(s[4] * inv - bflo(us.z), s[5] * inv - bfhi(us.z)); w.w = pk2(s[6] * inv - bflo(us.w), s[7] * inv - bfhi(us.w));
    *(u32x4*)(PL + (size_t)row * BW + c) = w;
}
__device__ __forceinline__ void conv_pool_phase(const Frame& F, const Args& a, int l, int nrows) {
    const bf16_t* Z = (const bf16_t*)(F.ws + WS_Z); bf16_t* BR = (bf16_t*)(F.ws + WS_BR); bf16_t* PL = (bf16_t*)(F.ws + WS_PL);
    const float* cw = a.in[I_CONVW] + (size_t)l * 3 * BW;
    const int nitems = (nrows / 2) * 4;
    for (int it = F.gw; it < nitems; it += F.NGW) {
        const int pg = it & 3, row = 2 * (it >> 2) + (F.lane >> 5), c = 256 * pg + 8 * (F.lane & 31); int lo, hi; seq_bounds(row, lo, hi);
        if (pg == 0) conv_pool_item<1>(Z, BR, PL, cw, row, c, lo, hi); else if (pg == 1) conv_pool_item<2>(Z, BR, PL, cw, row, c, lo, hi);
        else if (pg == 2) conv_pool_item<4>(Z, BR, PL, cw, row, c, lo, hi); else conv_pool_item<8>(Z, BR, PL, cw, row, c, lo, hi);
    }
}

__device__ __forceinline__ int ml_chunk_base(int ci, int b, int dir) {
    if (ci < 4) return ML + b * CT + (dir ? 3 - ci : ci) * CHK;
    return b * T + (dir ? 127 - (ci - 4) : ci - 4) * CHK;
}
constexpr int M2_HP = 260;
constexpr int ML_PF = 4;
constexpr int ML_RP = 80;
constexpr int ML_IMGB = 64 * ML_RP;
constexpr int ML_WAVE_BYTES = 2 * ML_IMGB;
__device__ __forceinline__ void mlstm_state_phase(const Frame& F, const Args& a, int l) {
    const bf16_t* Z = (const bf16_t*)(F.ws + WS_Z); const float* GATES = (const float*)(F.ws + WS_GATES);
    bf16_t* CIN = (bf16_t*)(F.ws + WS_CIN); float* NIN = (float*)(F.ws + WS_NIN); float* MIN_ = (float*)(F.ws + WS_MIN);
    LAS unsigned char* img = F.lds + F.wave * ML_WAVE_BYTES;
    LAS float* kwt = (LAS float*)(F.lds + NWAVES * ML_WAVE_BYTES);
    LAS float* gmx = kwt + NCHK * 64;
    LAS float* gbl = gmx + NCHK;
    LAS float* cdv = gbl + NCHK;
    LAS float* mv = cdv + NCHK;
    const float* gb = a.in[I_MGB] + (size_t)l * 16;
    const int lane = F.lane, w = F.wave, q = lane >> 4, c16 = lane & 15;
    for (int unit = blockIdx.x; unit < 256; unit += F.G) {
        const int chain = unit >> 4, sl = unit & 15, b = chain >> 3, h = (chain >> 1) & 3, dir = chain & 1;
        const float bi = gb[dir * 4 + h], bfg = gb[(2 + dir) * 4 + h];
        const bf16_t* kbase = (const bf16_t*)(F.ws + WS_KC) + (size_t)(h * 8 + w) * MT * 16; const bf16_t* vbase = (const bf16_t*)(F.ws + WS_VC) + (size_t)(h * 16 + sl) * MT * 16;
        __syncthreads();
        for (int ci = w; ci < NCHK; ci += NWAVES) {
            const int row_ = ml_chunk_base(ci, b, dir) + (dir ? 63 - lane : lane);
            const float li = GATES[(size_t)row_ * 16 + dir * 4 + h] + bi, lf = logsigmoid(GATES[(size_t)row_ * 16 + (2 + dir) * 4 + h] + bfg);
            float bc = lf;
#pragma unroll
            for (int o = 1; o < 64; o <<= 1) { const float x = __shfl_up(bc, o); if (lane >= o) bc += x; }
            const float av = li - bc, amax = wave_max(av), blast = __shfl(bc, 63);
            kwt[ci * 64 + lane] = av; if (lane == 0) { gmx[ci] = amax; gbl[ci] = blast; }
        }
        __syncthreads();
        if (w == 0) { float m = 0.f;
#pragma unroll 4
            for (int ci = 0; ci < NCHK; ++ci) { const float amax = gmx[ci], bl = gbl[ci]; const float mm = fmaxf(m, amax);
                if (lane == 0) { cdv[ci] = __expf(m - mm); mv[ci] = m; gmx[ci] = mm; }
                m = bl + mm; }
        }
        __syncthreads();
        for (int ci = w; ci < NCHK; ci += NWAVES) kwt[ci * 64 + lane] = __expf(kwt[ci * 64 + lane] - gmx[ci]);
        if (sl == 0 && w == 0) for (int ci = lane; ci < NCHK; ci += 64) MIN_[(size_t)chain * NCHK + ci] = mv[ci];
        __syncthreads();
        f32x4 acc = {0.f, 0.f, 0.f, 0.f}, accn = {0.f, 0.f, 0.f, 0.f};
        u32x4 pk[ML_PF][2], pv[ML_PF][2];
#define ML_LOAD(slot, ci_) do { const int row_ = ml_chunk_base((ci_), b, dir) + (dir ? 63 - lane : lane); const bf16_t* kr_ = kbase + (size_t)row_ * 16; const bf16_t* vr_ = vbase + (size_t)row_ * 16; \
            pk[slot][0] = *(const u32x4*)kr_; pk[slot][1] = *(const u32x4*)(kr_ + 8); pv[slot][0] = *(const u32x4*)vr_; pv[slot][1] = *(const u32x4*)(vr_ + 8); } while (0)
#define ML_SCALE(x4, k_) ((u32x4){pk2(bflo((x4).x) * (k_), bfhi((x4).x) * (k_)), pk2(bflo((x4).y) * (k_), bfhi((x4).y) * (k_)), pk2(bflo((x4).z) * (k_), bfhi((x4).z) * (k_)), pk2(bflo((x4).w) * (k_), bfhi((x4).w) * (k_))})
#define ML_WRITE_IMG(slot, ci_, buf_) do { LAS u32x4* d_ = (LAS u32x4*)(img + (buf_) * ML_IMGB + lane * ML_RP); const float kwj_ = kwt[(ci_) * 64 + lane]; \
            d_[0] = pk[slot][0]; d_[1] = pk[slot][1]; d_[2] = ML_SCALE(pv[slot][0], kwj_); d_[3] = ML_SCALE(pv[slot][1], kwj_); } while (0)
#pragma unroll
        for (int u = 0; u < ML_PF; ++u) ML_LOAD(u, u);
        ML_WRITE_IMG(0, 0, 0); ML_LOAD(0, ML_PF);
        LDS_WAIT();
        for (int c0 = 0; c0 < NCHK; c0 += ML_PF) {
#pragma unroll
            for (int u = 0; u < ML_PF; ++u) {
                const int ci = c0 + u, cur = ci & 1;
                const LAS unsigned char* ib = img + cur * ML_IMGB + (8 * q + (c16 >> 2)) * ML_RP + 8 * (lane & 3);
                typedef short s16x4 __attribute__((ext_vector_type(4)));
#define ML_TR(off_) __builtin_amdgcn_ds_read_tr16_b64_v4i16((LAS s16x4*)(ib + (off_)))
                const s16x4 ka0 = ML_TR(0), ka1 = ML_TR(4 * ML_RP), kb0 = ML_TR(32 * ML_RP), kb1 = ML_TR(36 * ML_RP);
                const s16x4 va0 = ML_TR(32), va1 = ML_TR(4 * ML_RP + 32), vb0 = ML_TR(32 * ML_RP + 32), vb1 = ML_TR(36 * ML_RP + 32);
#undef ML_TR
                const bf16x8 af0 = __builtin_shufflevector(ka0, ka1, 0, 1, 2, 3, 4, 5, 6, 7), af1 = __builtin_shufflevector(kb0, kb1, 0, 1, 2, 3, 4, 5, 6, 7);
                const bf16x8 bf0 = __builtin_shufflevector(va0, va1, 0, 1, 2, 3, 4, 5, 6, 7), bf1 = __builtin_shufflevector(vb0, vb1, 0, 1, 2, 3, 4, 5, 6, 7);
                u32x4 bn0 = {0u, 0u, 0u, 0u}, bn1 = {0u, 0u, 0u, 0u};
                if (sl == 0) { const LAS float* kp = kwt + ci * 64 + 8 * q; const f32x4 k0 = *(const LAS f32x4*)kp, k1 = *(const LAS f32x4*)(kp + 4), k2 = *(const LAS f32x4*)(kp + 32), k3 = *(const LAS f32x4*)(kp + 36);
                    const bool c0l = (c16 == 0);
                    bn0.x = c0l ? pk2(k0[0], k0[1]) : 0u; bn0.y = c0l ? pk2(k0[2], k0[3]) : 0u; bn0.z = c0l ? pk2(k1[0], k1[1]) : 0u; bn0.w = c0l ? pk2(k1[2], k1[3]) : 0u;
                    bn1.x = c0l ? pk2(k2[0], k2[1]) : 0u; bn1.y = c0l ? pk2(k2[2], k2[3]) : 0u; bn1.z = c0l ? pk2(k3[0], k3[1]) : 0u; bn1.w = c0l ? pk2(k3[2], k3[3]) : 0u; }
                const float cd = cdv[ci];
                { u32x2 cw; cw.x = pk2(acc[0], acc[1]); cw.y = pk2(acc[2], acc[3]);
                  *(u32x2*)(CIN + (((size_t)chain * NCHK + ci) * DV + sl * 16 + c16) * DK + 16 * w + 4 * q) = cw; }
                if (sl == 0 && c16 == 0) *(f32x4*)(NIN + ((size_t)chain * NCHK + ci) * DK + 16 * w + 4 * q) = accn;
                if (ci + 1 < NCHK) { ML_WRITE_IMG((u + 1) % ML_PF, ci + 1, cur ^ 1); if (ci + 1 + ML_PF < NCHK) ML_LOAD((u + 1) % ML_PF, ci + 1 + ML_PF); }
                LDS_WAIT();
                acc *= cd; accn *= cd;
                acc = __builtin_amdgcn_mfma_f32_16x16x32_bf16(af0, bf0, acc, 0, 0, 0);
                acc = __builtin_amdgcn_mfma_f32_16x16x32_bf16(af1, bf1, acc, 0, 0, 0);
                if (sl == 0) {
                    accn = __builtin_amdgcn_mfma_f32_16x16x32_bf16(af0, __builtin_bit_cast(bf16x8, bn0), accn, 0, 0, 0);
                    accn = __builtin_amdgcn_mfma_f32_16x16x32_bf16(af1, __builtin_bit_cast(bf16x8, bn1), accn, 0, 0, 0);
                }
            }
        }
#undef ML_LOAD
#undef ML_SCALE
#undef ML_WRITE_IMG
    }
    __syncthreads();
}

constexpr int M2_QP = 272, M2_VP = 144;
__device__ __forceinline__ void mlstm_out_phase(const Frame& F, const Args& a, int l, bool last) {
    const bf16_t* Z = (const bf16_t*)(F.ws + WS_Z); const float* GATES = (const float*)(F.ws + WS_GATES); bf16_t* BR = (bf16_t*)(F.ws + WS_BR);
    const bf16_t* CINT = (const bf16_t*)(F.ws + WS_CIN); const float* NIN = (const float*)(F.ws + WS_NIN); const float* MIN_ = (const float*)(F.ws + WS_MIN);
    LAS unsigned char* Qs = F.lds;
    LAS unsigned char* Ks = Qs + 64 * M2_QP;
    LAS unsigned char* Vt = Ks + 64 * M2_QP + F.wave * (32 * M2_VP);
    LAS unsigned char* Wb = Ks + 64 * M2_QP + 8 * (32 * M2_VP);
    LAS float* Ss = (LAS float*)(Wb + 64 * M2_VP);
    LAS float* vec = Ss + 64 * 65;
    const float* gb = a.in[I_MGB] + (size_t)l * 16;
    const float* gain = a.in[I_MNG] + (size_t)l * BW;
    const float qscale = 0.08838834764831845f;
    const int w = F.wave;
#define M2_IDS int t = F.tid; asm volatile("" : "+v"(t)); const int lane = t & 63, n = lane & 31, hh = lane >> 5; (void)n; (void)hh; (void)lane
    for (int unit = blockIdx.x; unit < NB * HEADS * NCHK; unit += F.G) {
        const int c = unit % NCHK, bh = unit / NCHK, b = bh >> 2, h = bh & 3;
        if (last && c < 4) continue;
        const int base = c < 4 ? ML + b * CT + c * CHK : b * T + (c - 4) * CHK;
        __syncthreads();
        u32x4 og[4];
        float gpre[4] = {0.f, 0.f, 0.f, 0.f}, npre[2] = {0.f, 0.f}, mpre[2];
        const float gbv[4] = {gb[h], gb[8 + h], gb[4 + h], gb[12 + h]};
        { M2_IDS; const u32x4* op = (const u32x4*)(Z + (size_t)(base + (t >> 3)) * ZW + ZC_O + h * DV + 32 * (t & 7));
#pragma unroll
          for (int j = 0; j < 4; ++j) og[j] = op[j];
#pragma unroll
          for (int d2 = 0; d2 < 2; ++d2) { const int chain = (b * 4 + h) * 2 + d2, ci = c < 4 ? (d2 ? 3 - c : c) : 4 + (d2 ? 127 - (c - 4) : c - 4);
              mpre[d2] = MIN_[(size_t)chain * NCHK + ci];
              { const int tg = t & 63; const size_t row = (size_t)(base + (d2 ? 63 - tg : tg)); gpre[2 * d2] = GATES[row * 16 + d2 * 4 + h]; gpre[2 * d2 + 1] = GATES[row * 16 + (2 + d2) * 4 + h]; }
              npre[d2] = NIN[((size_t)chain * NCHK + ci) * DK + ((t - 64) & (DK - 1))]; } }
        { M2_IDS;
        u32x4 qv[2], kv[2], v4[4];
#pragma unroll
        for (int i = 0; i < 2; ++i) { const int q = t + i * NTHR, j = q >> 4, part = q & 15; const size_t ro = (size_t)(base + j) * ZW;
            qv[i] = *(const u32x4*)(Z + ro + ZC_Q + h * DK + part * 8); kv[i] = *(const u32x4*)(Z + ro + ZC_K + h * DK + part * 8); }
        { const bf16_t* vr = Z + (size_t)(base + lane) * ZW + ZC_V + h * DV + 32 * w;
#pragma unroll
          for (int i = 0; i < 4; ++i) v4[i] = *(const u32x4*)(vr + 8 * i); }
        asm volatile("" ::: "memory");
#pragma unroll
        for (int i = 0; i < 2; ++i) { const int q = t + i * NTHR, j = q >> 4, part = q & 15;
            *(LAS u32x4*)(Qs + j * M2_QP + part * 16) = qv[i]; *(LAS u32x4*)(Ks + j * M2_QP + part * 16) = kv[i]; }
        {
#pragma unroll
            for (int i = 0; i < 4; ++i) { const u32x4 vv = v4[i]; LAS bf16_t* d0 = (LAS bf16_t*)(Vt + (8 * i) * M2_VP) + lane;
                d0[0 * (M2_VP / 2)] = (bf16_t)(vv.x & 0xffffu); d0[1 * (M2_VP / 2)] = (bf16_t)(vv.x >> 16); d0[2 * (M2_VP / 2)] = (bf16_t)(vv.y & 0xffffu); d0[3 * (M2_VP / 2)] = (bf16_t)(vv.y >> 16);
                d0[4 * (M2_VP / 2)] = (bf16_t)(vv.z & 0xffffu); d0[5 * (M2_VP / 2)] = (bf16_t)(vv.z >> 16); d0[6 * (M2_VP / 2)] = (bf16_t)(vv.w & 0xffffu); d0[7 * (M2_VP / 2)] = (bf16_t)(vv.w >> 16); }
        }
        }
        __syncthreads();
        if (w < 4) { M2_IDS;
            const int tt = w >> 1, st = w & 1; f32x16 sa;
#pragma unroll
            for (int i = 0; i < 16; ++i) sa[i] = 0.f;
#pragma unroll
            for (int ks = 0; ks < 8; ++ks) { const bf16x8 Af = *(const LAS bf16x8*)(Qs + (32 * tt + n) * M2_QP + 32 * ks + 16 * hh), Bq = *(const LAS bf16x8*)(Ks + (32 * st + n) * M2_QP + 32 * ks + 16 * hh);
                sa = __builtin_amdgcn_mfma_f32_32x32x16_bf16(Af, Bq, sa, 0, 0, 0); }
#pragma unroll
            for (int i = 0; i < 16; ++i) Ss[(32 * tt + (i & 3) + 8 * (i >> 2) + 4 * hh) * 65 + 32 * st + n] = sa[i] * qscale;
        } else if (w < 6) { M2_IDS;
            const int ds = w - 4; LAS float* vd = vec + (ds ? 576 : 0); const float m_in = ds ? mpre[1] : mpre[0];
            const float li = ds ? gpre[2] + gbv[2] : gpre[0] + gbv[0], lf = logsigmoid(ds ? gpre[3] + gbv[3] : gpre[1] + gbv[1]);
            float bc = lf;
#pragma unroll
            for (int o = 1; o < 64; o <<= 1) { const float x = __shfl_up(bc, o); if (lane >= o) bc += x; }
            const float av = li - bc; float pm = av;
#pragma unroll
            for (int o = 1; o < 64; o <<= 1) { const float x = __shfl_up(pm, o); if (lane >= o) pm = fmaxf(pm, x); }
            const float mx = fmaxf(pm, m_in), mt = bc + mx;
            vd[lane] = bc; vd[64 + lane] = av; vd[128 + lane] = mt; vd[192 + lane] = __expf(m_in - mx); vd[256 + lane] = __expf(-mt);
        } else { M2_IDS; const int k = (t - 64) & (DK - 1); vec[448 + k] = npre[0]; vec[896 + k] = npre[1]; }
        bf16x8 Vf[4];
        { M2_IDS;
#pragma unroll
        for (int ks = 0; ks < 4; ++ks) Vf[ks] = *(const LAS bf16x8*)(Vt + n * M2_VP + 32 * ks + 16 * hh); }
        f32x16 hs[2];
#pragma unroll
        for (int i = 0; i < 16; ++i) { hs[0][i] = 0.f; hs[1][i] = 0.f; }
#pragma nounroll
        for (int dir_ = 0; dir_ < 2; ++dir_) {
            int dir = dir_; asm volatile("" : "+s"(dir));
            const int chain = (b * 4 + h) * 2 + dir;
            const int ci = c < 4 ? (dir ? 3 - c : c) : 4 + (dir ? 127 - (c - 4) : c - 4);
            bf16x8 Cf[8];
            { M2_IDS; const bf16_t* cp = CINT + (((size_t)chain * NCHK + ci) * DV + 32 * w + n) * DK + 8 * hh;
#pragma unroll
              for (int ks = 0; ks < 8; ++ks) Cf[ks] = __builtin_bit_cast(bf16x8, *(const u32x4*)(cp + 16 * ks)); }
            __syncthreads();
            {   M2_IDS;
                const LAS float* vd = vec + (dir ? 576 : 0); const LAS float* nd = vec + (dir ? 896 : 448);
                const int tm = t >> 3, part = t & 7, j = dir ? 63 - tm : tm; const float bj = vd[j] - vd[128 + j];
                float wv[8], s = 0.f;
#pragma unroll
                for (int e = 0; e < 8; ++e) { const int sm = 8 * part + e, i = dir ? 63 - sm : sm; wv[e] = (i <= j) ? Ss[tm * 65 + sm] * __expf(bj + vd[64 + i]) : 0.f; s += wv[e]; }
                u32x4 pw; pw.x = pk2(wv[0], wv[1]); pw.y = pk2(wv[2], wv[3]); pw.z = pk2(wv[4], wv[5]); pw.w = pk2(wv[6], wv[7]);
                *(LAS u32x4*)(Wb + tm * M2_VP + 16 * part) = pw;
                float qn = 0.f; const LAS bf16_t* qr = (const LAS bf16_t*)(Qs + tm * M2_QP) + part * 16;
#pragma unroll
                for (int dd = 0; dd < 16; ++dd) qn += bf1(qr[dd]) * nd[part * 16 + dd];
                s += vd[192 + j] * qscale * qn;
                s += __shfl_xor(s, 1); s += __shfl_xor(s, 2); s += __shfl_xor(s, 4);
                if (part == 0) { const float inv = 1.f / fmaxf(fabsf(s), vd[256 + j]); vec[320 + tm] = inv; vec[384 + tm] = vd[192 + j] * qscale * inv; }
            }
            __syncthreads();
            { M2_IDS;
#pragma unroll
            for (int tt = 0; tt < 2; ++tt) {
                f32x16 n1, n2;
#pragma unroll
                for (int i = 0; i < 16; ++i) { n1[i] = 0.f; n2[i] = 0.f; }
#pragma unroll
                for (int ks = 0; ks < 4; ++ks) { const bf16x8 Af = *(const LAS bf16x8*)(Wb + (32 * tt + n) * M2_VP + 32 * ks + 16 * hh); n1 = __builtin_amdgcn_mfma_f32_32x32x16_bf16(Af, Vf[ks], n1, 0, 0, 0); }
                asm volatile("" ::: "memory");
#pragma unroll
                for (int ks = 0; ks < 8; ++ks) { const bf16x8 Af = *(const LAS bf16x8*)(Qs + (32 * tt + n) * M2_QP + 32 * ks + 16 * hh); n2 = __builtin_amdgcn_mfma_f32_32x32x16_bf16(Af, Cf[ks], n2, 0, 0, 0);
                    if (ks == 3) asm volatile("" ::: "memory"); }
                asm volatile("" ::: "memory");
#pragma unroll
                for (int i = 0; i < 16; ++i) { const int tm = 32 * tt + (i & 3) + 8 * (i >> 2) + 4 * hh; hs[tt][i] += n1[i] * vec[320 + tm] + n2[i] * vec[384 + tm]; }
                asm volatile("" ::: "memory");
            }
            }
        }
        __syncthreads();
        { M2_IDS; LAS float* HS = (LAS float*)F.lds;
#pragma unroll
          for (int tt = 0; tt < 2; ++tt)
#pragma unroll
            for (int i = 0; i < 16; ++i) HS[(32 * tt + (i & 3) + 8 * (i >> 2) + 4 * hh) * M2_HP + 32 * w + n] = hs[tt][i];
        }
        __syncthreads();
        { M2_IDS; const int tm = t >> 3, part = t & 7;
          const LAS f32x4* hr = (const LAS f32x4*)((const LAS float*)F.lds + tm * M2_HP + 32 * part);
          const f32x4* gp = (const f32x4*)(gain + h * DV + 32 * part);
          f32x4 x[8], gq[8]; float s = 0.f;
#pragma unroll
          for (int j = 0; j < 8; ++j) { x[j] = hr[j]; gq[j] = gp[j]; }
#pragma unroll
          for (int j = 0; j < 8; ++j) s += (x[j][0] * x[j][0] + x[j][1] * x[j][1]) + (x[j][2] * x[j][2] + x[j][3] * x[j][3]);
          s += __shfl_xor(s, 1); s += __shfl_xor(s, 2); s += __shfl_xor(s, 4);
          const float rs = 1.f / sqrtf(s * (1.f / DV) + EPS);
          bf16_t* bo = BR + (size_t)(base + tm) * D + 3072 + h * DV + 32 * part;
#pragma unroll
          for (int j = 0; j < 4; ++j) { const u32x4 o = og[j]; const f32x4 a0 = x[2 * j] * gq[2 * j] * rs, a1 = x[2 * j + 1] * gq[2 * j + 1] * rs; u32x4 pw;
              pw.x = pk2(a0[0] * sigm(bflo(o.x)), a0[1] * sigm(bfhi(o.x))); pw.y = pk2(a0[2] * sigm(bflo(o.y)), a0[3] * sigm(bfhi(o.y)));
              pw.z = pk2(a1[0] * sigm(bflo(o.z)), a1[1] * sigm(bfhi(o.z))); pw.w = pk2(a1[2] * sigm(bflo(o.w)), a1[3] * sigm(bfhi(o.w)));
              *(u32x4*)(bo + 8 * j) = pw; }
        }
    }
    __syncthreads();
#undef M2_IDS
}

__device__ __forceinline__ unsigned char* launder(unsigned char* p) { unsigned long long v = (unsigned long long)p; asm volatile("" : "+s"(v)); return (unsigned char*)(gchar_t*)v; }
__device__ __forceinline__ Frame make_frame(unsigned char* ws, LAS unsigned char* lds) {
    Frame F; F.lds = lds; { int t_ = threadIdx.x; asm volatile("" : "+v"(t_)); F.tid = t_; } F.lane = F.tid & 63; F.wave = __builtin_amdgcn_readfirstlane(F.tid >> 6);
    { int g_ = gridDim.x; asm volatile("" : "+s"(g_)); F.G = g_; } F.gw = blockIdx.x * NWAVES + F.wave; F.NGW = F.G * NWAVES; F.ws = ws; return F;
}
__global__ void __launch_bounds__(NTHR, 2) fwd_kernel(Args args) {
    extern __shared__ __attribute__((aligned(16))) unsigned char lds_raw[];
    LAS unsigned char* const lds = (LAS unsigned char*)lds_raw;
    { volatile LAS unsigned* MISC = (volatile LAS unsigned*)(lds + MISC_OFF);
      if (threadIdx.x < 64) MISC[threadIdx.x] = 0u;
      __syncthreads();
      if (args.use_bar) (void)xcd_barrier_post((unsigned*)(args.ws + WS_CTL), MISC + 8); }
    const int lo = args.ph_lo, hi = args.ph_hi;
#ifndef PH_EN
#define PH_EN 0xffff
#endif
#define IN(k) (lo <= (k) && (k) < hi)
#define EN(j) (((PH_EN) >> (j)) & 1)
#define SEAM(k) do { if (args.use_bar && IN((k) + 1)) { XcdBarrier b_; b_.bar = (unsigned*)(launder(args.ws) + WS_CTL); b_.x = xb_xcc_id(); b_.st = (volatile LAS unsigned*)(lds + MISC_OFF) + 8; xcd_barrier(b_); } } while (0)
#define PHASE_BEGIN unsigned char* ws = launder(args.ws); const Frame F = make_frame(ws, lds); (void)F
#define RUN_GEMM(EpiT, E, Aptr, Bptr, lda_, ldb_, K_, apn_, nM_, nN_) do { int k_ = (K_); asm volatile("" : "+s"(k_)); pg8::Gemm g_{(const bf16_t*)(Aptr), (const bf16_t*)(Bptr), (lda_), (ldb_), k_, (apn_)}; \
        pg8::StaticOrder S_; { int g2_ = gridDim.x, c2_ = blockIdx.x; asm volatile("" : "+s"(g2_), "+s"(c2_)); S_.init((nM_), (nN_), g2_, c2_); } pg8::gemm_phase<EpiT>(lds, g_, S_, E); } while (0)

    if (EN(13) && IN(0)) { PHASE_BEGIN; p0_transposes(F, args); SEAM(0); }
    if (EN(13) && IN(1)) { PHASE_BEGIN; p0_ada_reduce(F, args, 0, 1); SEAM(1); }

    for (int l = 0; l < NL; ++l) {
        const int pb = 2 + 13 * l;
#define LASTL (l == NL - 1)
#define NMO (LASTL ? 64 : 66)
#define NRO (LASTL ? ML : MT)
#define MODL ((const float*)(ws + WS_MOD) + (size_t)l * 3 * NADA)
        if (EN(0) && IN(pb + 0)) { PHASE_BEGIN; norm_phase(F, args, l, 0, MT, l == 0, false); SEAM(pb + 0); }
        if (EN(1) && IN(pb + 1)) { PHASE_BEGIN; EpiSwiglu E{(bf16_t*)(ws + WS_HID)};
            if (l == 0) { int k_ = D; asm volatile("" : "+s"(k_)); pg8::Gemm g_{(const bf16_t*)(ws + WS_U), (const bf16_t*)(ws + WS_W1IN), D, D, k_, 0};
                pg8::StaticOrder S_; { int g2_ = gridDim.x, c2_ = blockIdx.x; asm volatile("" : "+s"(g2_), "+s"(c2_)); S_.init(66, 48, g2_, c2_); }
                const int x_ = (S_.c & 7) + 1;
                S_.i1 = x_; pg8::gemm_phase<EpiSwiglu>(lds, g_, S_, E);
                slot_items(F, args); __syncthreads();
                S_.i0 = x_; S_.i1 = 0x7fffffff; pg8::gemm_phase<EpiSwiglu>(lds, g_, S_, E); }
            else RUN_GEMM(EpiSwiglu, E, ws + WS_U, ws + WS_W1IN + (size_t)(l * 2 + 0) * SZ_WFIN, D, D, D, 0, 66, 48);
            tail_items(F, args, 3168, l == 0 ? 0 : 35040, l == 0 ? 3300 : 38340); SEAM(pb + 1); }
        if (EN(2) && IN(pb + 2)) { PHASE_BEGIN; EpiResid E{(bf16_t*)(ws + WS_H), MODL + 2 * D, 0.5f, 0}; RUN_GEMM(EpiResid, E, ws + WS_HID, ws + WS_W1OUT + (size_t)(l * 2 + 0) * SZ_WFOUT, HIDP, DFF, DFF, 0, 66, 16); tail_items(F, args, 1056, l == 0 ? 3300 : 38340, l == 0 ? 12000 : 47040); SEAM(pb + 2); }
        if (EN(3) && IN(pb + 3)) { PHASE_BEGIN; norm_phase(F, args, l, 3, MT, false, (l & 1) != 0); if (l == 0) p0_ada_reduce(F, args, 1, NL); SEAM(pb + 3); }
        if (EN(4) && IN(pb + 4)) { PHASE_BEGIN; EpiWin E{(bf16_t*)(ws + WS_Z), (bf16_t*)(ws + WS_G), (float*)(ws + WS_GATES), (bf16_t*)(ws + WS_KC), (bf16_t*)(ws + WS_VC)}; { int k_ = D; asm volatile("" : "+s"(k_)); pg8::Gemm g_{(const bf16_t*)(ws + WS_U), (const bf16_t*)(ws + WS_WIN + (size_t)l * SZ_WIN), D, D, k_, 0};
              pg8::StaticOrder S_; { int g2_ = gridDim.x, c2_ = blockIdx.x; asm volatile("" : "+s"(g2_), "+s"(c2_)); S_.init(64, 97, g2_, c2_); } S_.add_extra(2, LASTL ? 32 : 96);
              pg8::gemm_phase<EpiWin>(lds, g_, S_, E); }
            ctx_gates(F, l); SEAM(pb + 4); }
        if (EN(5) && IN(pb + 5)) {
            { PHASE_BEGIN; s5_scan_phase(F, args, l); }
            { PHASE_BEGIN; mlstm_state_phase(F, args, l); }
            { PHASE_BEGIN; conv_pool_phase(F, args, l, NRO); }
            SEAM(pb + 5); }
        if (EN(6) && IN(pb + 6)) {
            { PHASE_BEGIN; s5_combine_phase(F, args, l, NRO); }
            { PHASE_BEGIN; mlstm_out_phase(F, args, l, LASTL); }
            SEAM(pb + 6); }
        if (EN(7) && IN(pb + 7)) {
            { PHASE_BEGIN; EpiGlu E{(const bf16_t*)(ws + WS_GS5), (bf16_t*)(ws + WS_BR), args.in[I_S5BGLU] + (size_t)l * BW}; RUN_GEMM(EpiGlu, E, ws + WS_GS5, ws + WS_WGLU + (size_t)l * SZ_WGLU, BW, BW, BW, 0, NMO, 4); }
            { PHASE_BEGIN; EpiPool E{(bf16_t*)(ws + WS_BR), args.in[I_POOLS] + (size_t)l * BW}; RUN_GEMM(EpiPool, E, ws + WS_PL, ws + WS_WPOOL + (size_t)l * SZ_WPOOL, BW, 256, 256, 256, NMO, 4); }
            SEAM(pb + 7); }
        if (EN(8) && IN(pb + 8)) { PHASE_BEGIN; EpiMerge2 E{(const bf16_t*)(ws + WS_G), (bf16_t*)(ws + WS_U), nullptr}; { int k_ = BW; asm volatile("" : "+s"(k_)); pg8::Gemm g_{(const bf16_t*)(ws + WS_BR), (const bf16_t*)(ws + WS_WBR + (size_t)l * SZ_WSQ), D, D, k_, 0};
              pg8::MergeOrder S_; { int g2_ = gridDim.x, c2_ = blockIdx.x; asm volatile("" : "+s"(g2_), "+s"(c2_)); S_.S.init(NMO, 16, g2_, c2_); E.SCR = ws + WS_MRG + (size_t)c2_ * 131072; }
              pg8::gemm_phase<EpiMerge2>(lds, g_, S_, E); }
            if (l == 0) tail_items(F, args, 1056, 12000, 15700); SEAM(pb + 8); }
        if (EN(9) && IN(pb + 9)) { PHASE_BEGIN; EpiResid E{(bf16_t*)(ws + WS_H), MODL + 5 * D, 1.0f, (l & 1)}; RUN_GEMM(EpiResid, E, ws + WS_U, ws + WS_WOUT + (size_t)l * SZ_WSQ, D, D, D, 0, NMO, 16); if (l == 0) tail_items(F, args, 1056, 15700, 23200); SEAM(pb + 9); }
        if (EN(10) && IN(pb + 10)) { PHASE_BEGIN; norm_phase(F, args, l, 6, NRO, false, false); SEAM(pb + 10); }
        if (EN(11) && IN(pb + 11)) { PHASE_BEGIN; EpiSwiglu E{(bf16_t*)(ws + WS_HID)}; RUN_GEMM(EpiSwiglu, E, ws + WS_U, ws + WS_W1IN + (size_t)(l * 2 + 1) * SZ_WFIN, D, D, D, 0, NMO, 48); if (l == 0) tail_items(F, args, 3168, 23200, 26500); SEAM(pb + 11); }
        if (EN(12) && IN(pb + 12)) { PHASE_BEGIN; EpiResid E{(bf16_t*)(ws + WS_H), MODL + 8 * D, 0.5f, 0}; RUN_GEMM(EpiResid, E, ws + WS_HID, ws + WS_W1OUT + (size_t)(l * 2 + 1) * SZ_WFOUT, HIDP, DFF, DFF, 0, NMO, 16); if (l == 0) tail_items(F, args, 1056, 26500, 35040); SEAM(pb + 12); }
    }
    if (EN(14) && IN(NPH - 1)) { PHASE_BEGIN; final_norm_phase(F, args); }
#undef IN
#undef EN
#undef SEAM
#undef RUN_GEMM
}


#ifndef DBG_STOP
#define DBG_STOP -1
#endif
#ifndef DBG_OFF
#define DBG_OFF (WS_WIN + (size_t)8192 * 4096 * 2)
#endif
#ifndef DBG_BF16
#define DBG_BF16 1
#endif
__global__ void dbg_dump(const unsigned char* src, int is_bf16, float* out, size_t n) {
    for (size_t i = (size_t)blockIdx.x * blockDim.x + threadIdx.x; i < n; i += (size_t)gridDim.x * blockDim.x) {
        float v = is_bf16 ? bf1(((const bf16_t*)src)[i]) : ((const float*)src)[i];
        if (!(v == v) || fabsf(v) > 1e30f) v = 12345.f;
        out[i] = v;
    }
}
extern "C" void kernel_launch(void* const* d_in, const int* in_sizes, int n_in, void* d_out, int out_size, void* d_ws, size_t ws_size, hipStream_t stream) {
    static int grid = 0;
    if (grid == 0) {
        if (n_in != 29 || out_size != ML * D || ws_size < WS_END) { fprintf(stderr, "kernel_launch: unexpected shapes (n_in %d out %d ws %zu need %zu)\n", n_in, out_size, ws_size, (size_t)WS_END); grid = -1; return; }
        int dev = 0, cus = 0, per_cu = 0;
        if (hipGetDevice(&dev) != hipSuccess || hipDeviceGetAttribute(&cus, hipDeviceAttributeMultiprocessorCount, dev) != hipSuccess) { grid = -1; return; }
        if (hipFuncSetAttribute((const void*)fwd_kernel, hipFuncAttributeMaxDynamicSharedMemorySize, LDS_BYTES) != hipSuccess) { fprintf(stderr, "kernel_launch: hipFuncSetAttribute failed\n"); grid = -1; return; }
        if (hipOccupancyMaxActiveBlocksPerMultiprocessor(&per_cu, (const void*)fwd_kernel, NTHR, LDS_BYTES) != hipSuccess || per_cu < 1) { fprintf(stderr, "kernel_launch: occupancy query says %d\n", per_cu); }
        (void)hipGetLastError();
        grid = cus > 0 ? cus : 256;
    }
    if (grid < 0) return;
    (void)hipMemsetAsync((char*)d_ws + WS_CTL, 0, CTL_BYTES, stream);
    Args a{};
    for (int i = 0; i < 29; ++i) a.in[i] = (const float*)d_in[i];
    a.out = (float*)d_out; a.ws = (unsigned char*)d_ws; a.pad = 0;
#if MK_ONE_LAUNCH
    a.ph_lo = 0; a.ph_hi = NPH; a.use_bar = 1;
    hipLaunchKernelGGL(fwd_kernel, dim3(grid), dim3(NTHR), LDS_BYTES, stream, a);
#else
    for (int ph = 0; ph < (DBG_STOP >= 0 ? DBG_STOP + 1 : NPH); ++ph) { a.ph_lo = ph; a.ph_hi = ph + 1; a.use_bar = 0; hipLaunchKernelGGL(fwd_kernel, dim3(grid), dim3(NTHR), LDS_BYTES, stream, a); }
#endif
#if DBG_STOP >= 0
    hipLaunchKernelGGL(dbg_dump, dim3(2048), dim3(256), 0, stream, (const unsigned char*)d_ws + (DBG_OFF), (int)(DBG_BF16), (float*)d_out, (size_t)ML * D);
#endif
}
```

```cpp
#include <hip/hip_runtime.h>
#include <cstdio>
#include <cstdint>

#ifndef MK_ONE_LAUNCH
#define MK_ONE_LAUNCH 1
#endif

#define LAS __attribute__((address_space(3)))
typedef __attribute__((address_space(1))) unsigned char gchar_t;
typedef unsigned short bf16_t;
typedef short bf16x8 __attribute__((ext_vector_type(8)));
typedef float f32x4 __attribute__((ext_vector_type(4)));
typedef float f32x2 __attribute__((ext_vector_type(2)));
typedef unsigned u32x4 __attribute__((ext_vector_type(4)));
typedef unsigned u32x2 __attribute__((ext_vector_type(2)));

constexpr int D = 4096, NB = 2, T = 8192, CT = 256, NL = 2;
constexpr int ML = NB * T;
constexpr int MC = NB * CT;
constexpr int MT = ML + MC;
constexpr int DFF = 6144, BW = 1024, NMOD = 9, NADA = NMOD * D;
constexpr int NIN = 24592, NINP = 24832;
constexpr int ZW = 8192;
constexpr int GW = 16384;
constexpr int HEADS = 4, DK = 128, DV = 256, CHK = 64;
constexpr int NCHK = (T + CT) / CHK;
constexpr int S5G = 64, S5P = 16, S5N = 64;
constexpr float EPS = 1e-6f;
constexpr int ZC_S5 = 0, ZC_CH = 1024, ZC_CB = 2048, ZC_CC = 3072, ZC_PL = 4096, ZC_Q = 5120, ZC_K = 5632, ZC_V = 6144, ZC_O = 7168;

constexpr size_t MiB = 1u << 20;
constexpr size_t al(size_t x) { return (x + 255) & ~(size_t)255; }
constexpr size_t WS_CTL = 0, CTL_BYTES = 1 * MiB;
constexpr size_t WS_MOD = WS_CTL + CTL_BYTES;
constexpr size_t WS_W1IN = al(WS_MOD + (size_t)NL * 3 * NADA * 4);
constexpr size_t SZ_WFIN = (size_t)2 * DFF * D * 2;
constexpr size_t WS_W1OUT = al(WS_W1IN + (size_t)NL * 2 * SZ_WFIN);
constexpr size_t SZ_WFOUT = (size_t)D * DFF * 2;
constexpr size_t WS_WIN = al(WS_W1OUT + (size_t)NL * 2 * SZ_WFOUT);
constexpr size_t SZ_WIN = (size_t)NINP * D * 2;
constexpr size_t WS_WGLU = al(WS_WIN + (size_t)NL * SZ_WIN);
constexpr size_t SZ_WGLU = (size_t)BW * BW * 2;
constexpr size_t WS_WPOOL = al(WS_WGLU + (size_t)NL * SZ_WGLU);
constexpr size_t SZ_WPOOL = (size_t)BW * 256 * 2;
constexpr size_t WS_WBR = al(WS_WPOOL + (size_t)NL * SZ_WPOOL);
constexpr size_t SZ_WSQ = (size_t)D * D * 2;
constexpr size_t WS_WOUT = al(WS_WBR + (size_t)NL * SZ_WSQ);
constexpr size_t WS_H = al(WS_WOUT + (size_t)NL * SZ_WSQ);
constexpr size_t WS_U = al(WS_H + (size_t)MT * D * 4);
constexpr int HIDP = DFF + 128;
constexpr size_t WS_HID = al(WS_U + (size_t)MT * D * 2);
constexpr size_t WS_Z = al(WS_HID + (size_t)MT * HIDP * 2);
constexpr size_t WS_GATES = al(WS_Z + (size_t)MT * ZW * 2);
constexpr size_t WS_G = al(WS_GATES + (size_t)MT * 16 * 4);
constexpr size_t WS_BR = al(WS_G + (size_t)MT * GW * 2);
constexpr size_t WS_MRG = al(WS_BR + (size_t)MT * D * 2);
constexpr size_t WS_YP = al(WS_MRG + (size_t)MT * D * 4);
constexpr size_t WS_GS5 = al(WS_YP + (size_t)2 * MT * BW * 4);
constexpr size_t WS_PL = al(WS_GS5 + (size_t)MT * BW * 2);
constexpr size_t WS_CIN = al(WS_PL + (size_t)MT * BW * 2);
constexpr size_t WS_NIN = al(WS_CIN + (size_t)16 * NCHK * DK * DV * 2);
constexpr size_t WS_MIN = al(WS_NIN + (size_t)16 * NCHK * DK * 4);
constexpr size_t WS_KC = al(WS_MIN + (size_t)16 * NCHK * 4);
constexpr size_t WS_VC = al(WS_KC + (size_t)HEADS * 8 * MT * 16 * 2);
constexpr size_t WS_ADAP = al(WS_VC + (size_t)HEADS * 16 * MT * 16 * 2);
constexpr size_t WS_END = al(WS_ADAP + (size_t)NL * 16 * 3 * NADA * 4);

typedef __bf16 bf16x2_t __attribute__((ext_vector_type(2)));
__device__ __forceinline__ unsigned pk2(float lo, float hi) { f32x2 v = {lo, hi}; bf16x2_t b = __builtin_convertvector(v, bf16x2_t); return __builtin_bit_cast(unsigned, b); }
__device__ __forceinline__ float bflo(unsigned w) { return __uint_as_float(w << 16); }
__device__ __forceinline__ float bfhi(unsigned w) { return __uint_as_float(w & 0xffff0000u); }
__device__ __forceinline__ float bf1(bf16_t b) { return __uint_as_float((unsigned)b << 16); }
__device__ __forceinline__ float wave_sum(float v) {
#pragma unroll
    for (int o = 1; o < 64; o <<= 1) v += __shfl_xor(v, o);
    return v;
}
__device__ __forceinline__ float wave_max(float v) {
#pragma unroll
    for (int o = 1; o < 64; o <<= 1) v = fmaxf(v, __shfl_xor(v, o));
    return v;
}
__device__ __forceinline__ float sigm(float x) { return __builtin_amdgcn_rcpf(1.f + __expf(-x)); }
__device__ __forceinline__ float siluf_(float x) { return x * sigm(x); }
__device__ __forceinline__ float gelu_tanh(float x) { const float z = 0.7978845608028654f * (x + 0.044715f * x * x * x); return x * sigm(2.f * z); }
__device__ __forceinline__ float logsigmoid(float x) { return fminf(x, 0.f) - log1pf(expf(-fabsf(x))); }
#define LDS_WAIT() asm volatile("s_waitcnt lgkmcnt(0)" ::: "memory")
#define VM_WAIT() asm volatile("s_waitcnt vmcnt(0)" ::: "memory")

namespace pg8 {
constexpr int BM = 256, BK = 64, HALF = 128, HTB = HALF * BK * 2, STAGE_BYTES = 8 * HTB, NXCD = 8, WGM = 4;
__host__ __device__ __forceinline__ int lds_byte(int r, int c) { const int st = (r >> 4) * 2 + (c >> 5), rr = r & 15, cc = c & 31, ob = rr * 64 + cc * 2; return st * 1024 + (ob ^ (((ob >> 9) & 1) << 5)); }
__host__ __device__ __forceinline__ void stage_rc(int b, int& R, int& C) { const int st = b / 1024, sb = b % 1024, swz = sb ^ (((sb >> 9) & 1) << 5); R = (st >> 1) * 16 + swz / 64; C = (st & 1) * 32 + (swz % 64) / 2; }
__host__ __device__ __forceinline__ int perm32(int rho) { const int n = rho >> 4, i = rho & 15; return 8 * (i >> 2) + 4 * n + (i & 3); }

struct Unit { int pm, pn, kb; };
struct Gemm { const bf16_t* A; const bf16_t* Bt; int lda, ldb, K, a_pn_off; };

struct StaticOrder {
    int nM, nN, nwg, G, c, nmain, xM, xN, i0, i1;
    __device__ void init(int nM_, int nN_, int G_, int c_) { nM = nM_; nN = nN_; nmain = nM * nN; nwg = nmain; G = G_; c = c_; xM = 0; xN = 0; i0 = 0; i1 = 0x7fffffff; }
    __device__ void add_extra(int xM_, int xN_) { xM = xM_; xN = xN_; nwg = nmain + xM * xN; }
    static constexpr bool KB = false;
    __device__ bool next(int i, Unit& u) const {
        u.kb = 0;
        const int ii = i + i0; if (ii >= i1) return false;
        const long L = (long)ii * G + c; if (L >= nwg) return false;
        int wgid = (int)L; { const int q = nwg / NXCD, r = nwg % NXCD, xcd = wgid % NXCD, off = wgid / NXCD; wgid = (xcd < r ? xcd * (q + 1) : r * (q + 1) + (xcd - r) * q) + off; }
        if (wgid >= nmain) { const int e = wgid - nmain; u.pm = nM + e % xM; u.pn = e / xM; return true; }
        const int nig = WGM * nN, gid = wgid / nig, fm = gid * WGM, gsz = (nM - fm) < WGM ? (nM - fm) : WGM;
        u.pm = fm + ((wgid % nig) % gsz); u.pn = (wgid % nig) / gsz; return true;
    }
};
struct MergeOrder {
    StaticOrder S;
    static constexpr bool KB = true;
    __device__ bool next(int i, Unit& u) const { if (!S.next(i >> 2, u)) return false; u.kb = i & 3; return true; }
};

template <class Epi, class Order>
__device__ __forceinline__ void gemm_phase(LAS unsigned char* lds, const Gemm g, const Order& S, const Epi& E) {
    int tid_ = threadIdx.x; asm volatile("" : "+v"(tid_));
    const int tid = tid_, wid = __builtin_amdgcn_readfirstlane(tid >> 6), lane = tid & 63, wr = wid >> 2, wc = wid & 3, fr = lane & 15, fq = lane >> 4;
    const int K = g.K, nt = K / BK;
    unsigned voffA[2], voffB[2];
#pragma unroll
    for (int i = 0; i < 2; ++i) { int R, C; stage_rc(tid * 16 + i * 8192, R, C); const int Rb = Epi::PERM ? ((R & ~31) + perm32(R & 31)) : R;
        voffA[i] = (unsigned)(R * g.lda + C) * 2u; voffB[i] = (unsigned)(Rb * g.ldb + C) * 2u; }
    const unsigned kstep = (unsigned)(BK * 2);
    const unsigned hstepA = (unsigned)HALF * g.lda * 2, hstepB = (unsigned)HALF * g.ldb * 2;
    const unsigned tstepA = 2 * hstepA, tstepB = 2 * hstepB;
    const unsigned pnA = (unsigned)g.a_pn_off * 2;
    const __amdgpu_buffer_rsrc_t rA_ = __builtin_amdgcn_make_buffer_rsrc((void*)g.A, 0, 0x7fffffff, 0x00020000), rB_ = __builtin_amdgcn_make_buffer_rsrc((void*)g.Bt, 0, 0x7fffffff, 0x00020000);
    const unsigned ldsw = (unsigned)wid * 1024u;
    const int aoff = lds_byte(wr * 64 + fr, fq * 8), boff = lds_byte(wc * 32 + fr, fq * 8);
#define PG8_SA(b, h) (((b) * 2 + (h)) * HTB)
#define PG8_SB(b, h) ((4 + (b) * 2 + (h)) * HTB)
#define PG8_STAGE_X(r_, bufoff, soff, voff) do { _Pragma("unroll") for (int _i = 0; _i < 2; ++_i) \
        __builtin_amdgcn_raw_ptr_buffer_load_lds((r_), (LAS void*)(lds + (bufoff) + ldsw + _i * 8192), 16, (voff)[_i], (int)(soff), 0, 0); } while (0)
#define PG8_LDA(dst, b, h) do { _Pragma("unroll") for (int m = 0; m < 4; ++m) _Pragma("unroll") for (int k = 0; k < 2; ++k) dst[m][k] = *(const LAS bf16x8*)(lds + PG8_SA(b, h) + aoff + m * 2048 + k * 1024); } while (0)
#define PG8_LDB(dst, b, h) do { _Pragma("unroll") for (int n = 0; n < 2; ++n) _Pragma("unroll") for (int k = 0; k < 2; ++k) dst[n][k] = *(const LAS bf16x8*)(lds + PG8_SB(b, h) + boff + n * 2048 + k * 1024); } while (0)
#define PG8_MMA(ai, bj, At, Bt) do { __builtin_amdgcn_s_setprio(1); _Pragma("unroll") for (int m = 0; m < 4; ++m) _Pragma("unroll") for (int n = 0; n < 2; ++n) _Pragma("unroll") for (int k = 0; k < 2; ++k) \
        acc[ai][bj][m][n] = __builtin_amdgcn_mfma_f32_16x16x32_bf16(Bt[n][k], At[m][k], acc[ai][bj][m][n], 0, 0, 0); __builtin_amdgcn_s_setprio(0); } while (0)
#define PG8_WAIT_V(n) asm volatile("s_waitcnt vmcnt(" #n ")" ::: "memory")
#define PG8_WAIT_L(n) asm volatile("s_waitcnt lgkmcnt(" #n ")" ::: "memory")
#define PG8_BAR __builtin_amdgcn_s_barrier()
#define PG8_SCHED __builtin_amdgcn_sched_barrier(0)
    Unit cur, nxt; int ui = 0;
    if (!S.next(0, cur)) return;
    f32x4 acc[2][2][4][2];
#pragma unroll
    for (int a = 0; a < 2; ++a)
#pragma unroll
        for (int b = 0; b < 2; ++b)
#pragma unroll
            for (int m = 0; m < 4; ++m)
#pragma unroll
                for (int n = 0; n < 2; ++n) acc[a][b][m][n] = (f32x4){0.f, 0.f, 0.f, 0.f};
    bf16x8 At[4][2], B0[2][2], B1[2][2];
    const unsigned kbstep = Order::KB ? (unsigned)K * 2 : 0;
    unsigned cA = cur.pm * tstepA + cur.pn * pnA + cur.kb * kbstep, cB = cur.pn * tstepB + cur.kb * kbstep;
    PG8_STAGE_X(rB_, PG8_SB(0, 0), cB, voffB); PG8_STAGE_X(rB_, PG8_SB(0, 1), cB + hstepB, voffB); PG8_STAGE_X(rA_, PG8_SA(0, 0), cA, voffA); PG8_STAGE_X(rA_, PG8_SA(0, 1), cA + hstepA, voffA);
    if (wr == 1) PG8_BAR;
    PG8_WAIT_V(2); PG8_BAR;
    PG8_STAGE_X(rB_, PG8_SB(1, 0), cB + kstep, voffB); PG8_STAGE_X(rA_, PG8_SA(1, 0), cA + kstep, voffA); PG8_STAGE_X(rB_, PG8_SB(1, 1), cB + hstepB + kstep, voffB);
    PG8_WAIT_V(6); PG8_BAR;
    for (;;) {
        const bool has_next = S.next(ui + 1, nxt);
        const unsigned nA = has_next ? nxt.pm * tstepA + nxt.pn * pnA + nxt.kb * kbstep : cA, nB = has_next ? nxt.pn * tstepB + nxt.kb * kbstep : cB;
        for (int t = 0; t < nt; t += 2) {
            const bool last = (t == nt - 2);
            const unsigned a1 = cA + (unsigned)(t + 1) * kstep;
            const unsigned a2 = last ? nA : cA + (unsigned)(t + 2) * kstep, b2 = last ? nB : cB + (unsigned)(t + 2) * kstep;
            const unsigned a3 = a2 + kstep, b3 = b2 + kstep;
            PG8_LDB(B0, 0, 0); PG8_LDB(B1, 0, 1); PG8_SCHED; PG8_LDA(At, 0, 0); PG8_STAGE_X(rA_, PG8_SA(1, 1), a1 + hstepA, voffA);
            PG8_WAIT_V(8); PG8_WAIT_L(0); PG8_BAR; PG8_MMA(0, 0, At, B0); PG8_MMA(0, 1, At, B1); PG8_BAR; PG8_SCHED;
            PG8_LDA(At, 0, 1); PG8_STAGE_X(rB_, PG8_SB(0, 0), b2, voffB); PG8_STAGE_X(rB_, PG8_SB(0, 1), b2 + hstepB, voffB); PG8_STAGE_X(rA_, PG8_SA(0, 0), a2, voffA);
            PG8_WAIT_V(8); PG8_WAIT_L(0); PG8_BAR; PG8_MMA(1, 0, At, B0); PG8_MMA(1, 1, At, B1); PG8_BAR; PG8_SCHED;
            PG8_LDB(B0, 1, 0); PG8_LDB(B1, 1, 1); PG8_SCHED; PG8_LDA(At, 1, 0); PG8_STAGE_X(rA_, PG8_SA(0, 1), a2 + hstepA, voffA);
            PG8_WAIT_V(8); PG8_WAIT_L(0); PG8_BAR; PG8_MMA(0, 0, At, B0); PG8_MMA(0, 1, At, B1); PG8_BAR; PG8_SCHED;
            PG8_LDA(At, 1, 1); PG8_STAGE_X(rB_, PG8_SB(1, 0), b3, voffB); PG8_STAGE_X(rB_, PG8_SB(1, 1), b3 + hstepB, voffB); PG8_STAGE_X(rA_, PG8_SA(1, 0), a3, voffA);
            PG8_WAIT_V(8); PG8_WAIT_L(0); PG8_BAR; PG8_MMA(1, 0, At, B0); PG8_MMA(1, 1, At, B1); PG8_BAR; PG8_SCHED;
        }
        if (wr == 0) PG8_BAR;
        E(acc, cur, wr, wc, fr, fq);
        if (!has_next) break;
#pragma unroll
        for (int a = 0; a < 2; ++a)
#pragma unroll
            for (int b = 0; b < 2; ++b)
#pragma unroll
                for (int m = 0; m < 4; ++m)
#pragma unroll
                    for (int n = 0; n < 2; ++n) acc[a][b][m][n] = (f32x4){0.f, 0.f, 0.f, 0.f};
        cur = nxt; cA = nA; cB = nB; ++ui;
        if (wr == 1) PG8_BAR;
    }
    PG8_WAIT_V(0);
    PG8_BAR;
#undef PG8_SA
#undef PG8_SB
#undef PG8_STAGE_X
#undef PG8_LDA
#undef PG8_LDB
#undef PG8_MMA
#undef PG8_WAIT_V
#undef PG8_WAIT_L
#undef PG8_BAR
#undef PG8_SCHED
}

}

__device__ __forceinline__ int seq2raster(int row) {
    if (row >= ML) return row;
    const int b = row >> 13, s = row & (T - 1), c = s >> 7, rw = s & 127;
    return (b << 13) + rw * 64 + c;
}
__device__ __forceinline__ int raster2seq(int row) {
    if (row >= ML) return row;
    const int b = row >> 13, t = row & (T - 1), rw = t >> 6, c = t & 63;
    return (b << 13) + c * 128 + rw;
}
typedef const f32x4 (&AccRef)[2][2][4][2];

struct EpiSwiglu {
    static constexpr bool PERM = true;
    bf16_t* HID;
    __device__ __forceinline__ void operator()(AccRef acc, const pg8::Unit& u, int wr, int wc, int fr, int fq) const {
        const int row0 = u.pm * 256 + wr * 64 + fr, col0 = u.pn * 128 + wc * 32 + 8 * fq;
#pragma unroll
        for (int ai = 0; ai < 2; ++ai)
#pragma unroll
            for (int m = 0; m < 4; ++m) {
                const f32x4 a0 = acc[ai][0][m][0], a1 = acc[ai][0][m][1], g0 = acc[ai][1][m][0], g1 = acc[ai][1][m][1];
                u32x4 w;
                w.x = pk2(siluf_(g0[0]) * a0[0], siluf_(g0[1]) * a0[1]); w.y = pk2(siluf_(g0[2]) * a0[2], siluf_(g0[3]) * a0[3]);
                w.z = pk2(siluf_(g1[0]) * a1[0], siluf_(g1[1]) * a1[1]); w.w = pk2(siluf_(g1[2]) * a1[2], siluf_(g1[3]) * a1[3]);
                *(u32x4*)(HID + (size_t)(row0 + ai * 128 + m * 16) * HIDP + col0) = w;
            }
    }
};
struct EpiResid {
    static constexpr bool PERM = true;
    bf16_t* H; const float* mod; float scale; int permute;
    __device__ __forceinline__ void operator()(AccRef acc, const pg8::Unit& u, int wr, int wc, int fr, int fq) const {
        const int row0 = u.pm * 256 + wr * 64 + fr, cw = u.pn * 256 + wc * 32 + 8 * fq;
        const float* mv = mod + (size_t)(u.pm < 64 ? (u.pm >> 5) : 2) * NADA;
        f32x4 mm[2][2];
#pragma unroll
        for (int bj = 0; bj < 2; ++bj)
#pragma unroll
            for (int n = 0; n < 2; ++n) mm[bj][n] = *(const f32x4*)(mv + cw + bj * 128 + 4 * n) * scale;
        u32x4 hh[4][2], w0[4][2];
#define ER_LOAD(ai) do { _Pragma("unroll") for (int m = 0; m < 4; ++m) { const int row = row0 + (ai) * 128 + m * 16; const int drow = permute ? seq2raster(row) : row; const bf16_t* hp = H + (size_t)drow * D + cw; \
            hh[m][0] = *(const u32x4*)hp; hh[m][1] = *(const u32x4*)(hp + 128); } } while (0)
#define ER_MATH(ai, dst) do { _Pragma("unroll") for (int m = 0; m < 4; ++m) _Pragma("unroll") for (int bj = 0; bj < 2; ++bj) { const u32x4 h_ = hh[m][bj]; const f32x4 v0 = mm[bj][0] * acc[ai][bj][m][0], v1 = mm[bj][1] * acc[ai][bj][m][1]; \
            dst[m][bj].x = pk2(bflo(h_.x) + v0[0], bfhi(h_.x) + v0[1]); dst[m][bj].y = pk2(bflo(h_.y) + v0[2], bfhi(h_.y) + v0[3]); dst[m][bj].z = pk2(bflo(h_.z) + v1[0], bfhi(h_.z) + v1[1]); dst[m][bj].w = pk2(bflo(h_.w) + v1[2], bfhi(h_.w) + v1[3]); } } while (0)
#define ER_STORE(ai, src) do { _Pragma("unroll") for (int m = 0; m < 4; ++m) { const int row = row0 + (ai) * 128 + m * 16; const int drow = permute ? seq2raster(row) : row; bf16_t* hp = H + (size_t)drow * D + cw; \
            *(u32x4*)hp = src[m][0]; *(u32x4*)(hp + 128) = src[m][1]; } } while (0)
        ER_LOAD(0);
        ER_MATH(0, w0);
        asm volatile("" ::: "memory");
        ER_LOAD(1);
        asm volatile("" ::: "memory");
        ER_STORE(0, w0);
        ER_MATH(1, w0);
        ER_STORE(1, w0);
#undef ER_LOAD
#undef ER_MATH
#undef ER_STORE
    }
};
struct EpiWin {
    static constexpr bool PERM = true;
    bf16_t* Z; bf16_t* G; float* GATES; bf16_t* KC; bf16_t* VC;
    __device__ __forceinline__ void operator()(AccRef acc, const pg8::Unit& u, int wr, int wc, int fr, int fq) const {
        const int row0 = u.pm * 256 + wr * 64 + fr, cw = wc * 32 + 8 * fq;
        if (u.pn < 32) {
#pragma unroll
            for (int ai = 0; ai < 2; ++ai)
#pragma unroll
                for (int m = 0; m < 4; ++m)
#pragma unroll
                    for (int bj = 0; bj < 2; ++bj) { const f32x4 v0 = acc[ai][bj][m][0], v1 = acc[ai][bj][m][1]; u32x4 w; w.x = pk2(v0[0], v0[1]); w.y = pk2(v0[2], v0[3]); w.z = pk2(v1[0], v1[1]); w.w = pk2(v1[2], v1[3]);
                        const int row = row0 + ai * 128 + m * 16, col = u.pn * 256 + bj * 128 + cw;
                        *(u32x4*)(Z + (size_t)row * ZW + col) = w;
                        if (u.pn >= 22 && u.pn < 24) { const int kc = col - ZC_K; *(u32x4*)(KC + ((size_t)(kc >> 4) * MT + row) * 16 + (kc & 15)) = w; }
                        else if (u.pn >= 24 && u.pn < 28) { const int vc = col - ZC_V; *(u32x4*)(VC + ((size_t)(vc >> 4) * MT + row) * 16 + (vc & 15)) = w; } }
        } else if (u.pn < 96) {
#pragma unroll
            for (int ai = 0; ai < 2; ++ai)
#pragma unroll
                for (int m = 0; m < 4; ++m)
#pragma unroll
                    for (int bj = 0; bj < 2; ++bj) { const f32x4 v0 = acc[ai][bj][m][0], v1 = acc[ai][bj][m][1]; u32x4 w;
                        w.x = pk2(sigm(v0[0]), sigm(v0[1])); w.y = pk2(sigm(v0[2]), sigm(v0[3])); w.z = pk2(sigm(v1[0]), sigm(v1[1])); w.w = pk2(sigm(v1[2]), sigm(v1[3]));
                        *(u32x4*)(G + (size_t)(row0 + ai * 128 + m * 16) * GW + (u.pn - 32) * 256 + bj * 128 + cw) = w; }
        } else if (wc == 0 && fq < 2) {
#pragma unroll
            for (int ai = 0; ai < 2; ++ai)
#pragma unroll
                for (int m = 0; m < 4; ++m) { float* gp = GATES + (size_t)(row0 + ai * 128 + m * 16) * 16 + 8 * fq; *(f32x4*)gp = acc[ai][0][m][0]; *(f32x4*)(gp + 4) = acc[ai][0][m][1]; }
        }
    }
};
struct EpiGlu {
    static constexpr bool PERM = true;
    const bf16_t* GS5; bf16_t* BR; const float* bglu;
    __device__ __forceinline__ void operator()(AccRef acc, const pg8::Unit& u, int wr, int wc, int fr, int fq) const {
        const int row0 = u.pm * 256 + wr * 64 + fr, cw = u.pn * 256 + wc * 32 + 8 * fq;
#pragma unroll
        for (int bj = 0; bj < 2; ++bj) { const int col = cw + bj * 128; const f32x4 b0 = *(const f32x4*)(bglu + col), b1 = *(const f32x4*)(bglu + col + 4);
#pragma unroll
            for (int ai = 0; ai < 2; ++ai)
#pragma unroll
                for (int m = 0; m < 4; ++m) { const size_t row = (size_t)(row0 + ai * 128 + m * 16); const u32x4 g = *(const u32x4*)(GS5 + row * BW + col);
                    const f32x4 v0 = acc[ai][bj][m][0] + b0, v1 = acc[ai][bj][m][1] + b1; u32x4 w;
                    w.x = pk2(bflo(g.x) * sigm(v0[0]), bfhi(g.x) * sigm(v0[1])); w.y = pk2(bflo(g.y) * sigm(v0[2]), bfhi(g.y) * sigm(v0[3]));
                    w.z = pk2(bflo(g.z) * sigm(v1[0]), bfhi(g.z) * sigm(v1[1])); w.w = pk2(bflo(g.w) * sigm(v1[2]), bfhi(g.w) * sigm(v1[3]));
                    *(u32x4*)(BR + row * D + col) = w; asm volatile("" ::: "memory"); } }
    }
};
struct EpiPool {
    static constexpr bool PERM = true;
    bf16_t* BR; const float* scale;
    __device__ __forceinline__ void operator()(AccRef acc, const pg8::Unit& u, int wr, int wc, int fr, int fq) const {
        const int row0 = u.pm * 256 + wr * 64 + fr, cw = u.pn * 256 + wc * 32 + 8 * fq;
#pragma unroll
        for (int bj = 0; bj < 2; ++bj) { const int col = cw + bj * 128; const f32x4 s0 = *(const f32x4*)(scale + col), s1 = *(const f32x4*)(scale + col + 4);
#pragma unroll
            for (int ai = 0; ai < 2; ++ai)
#pragma unroll
                for (int m = 0; m < 4; ++m) { const size_t row = (size_t)(row0 + ai * 128 + m * 16); const f32x4 v0 = acc[ai][bj][m][0] * s0, v1 = acc[ai][bj][m][1] * s1; u32x4 w;
                    w.x = pk2(v0[0], v0[1]); w.y = pk2(v0[2], v0[3]); w.z = pk2(v1[0], v1[1]); w.w = pk2(v1[2], v1[3]);
                    *(u32x4*)(BR + row * D + 2048 + col) = w; } }
    }
};
struct EpiMerge2 {
    static constexpr bool PERM = true;
    const bf16_t* G; bf16_t* U; unsigned char* SCR;
    __device__ __forceinline__ void operator()(AccRef acc, const pg8::Unit& u, int wr, int wc, int fr, int fq) const {
        const unsigned char* gb = (const unsigned char*)(G + (size_t)(u.pm * 256 + wr * 64) * GW + u.kb * 4096 + u.pn * 256 + wc * 32);
        unsigned char* ub = (unsigned char*)(U + (size_t)(u.pm * 256 + wr * 64) * D + u.pn * 256 + wc * 32);
        unsigned char* sb = SCR + (wr * 4 + wc) * 1024;
        unsigned go = (unsigned)(fr * GW + 8 * fq) * 2u, uo = (unsigned)(fr * D + 8 * fq) * 2u, so = (unsigned)(fq * 16 + fr) * 16u;
        asm volatile("" : "+v"(go), "+v"(uo), "+v"(so));
        const bool rd = u.kb != 0, fin = u.kb == 3;
        u32x4 gg[4][2], ms[4][2];
#define EM_LOAD(ai) do { _Pragma("unroll") for (int m = 0; m < 4; ++m) _Pragma("unroll") for (int bj = 0; bj < 2; ++bj) { gg[m][bj] = *(const u32x4*)(gb + ((size_t)((ai) * 128 + m * 16) * GW + bj * 128) * 2 + go); \
            ms[m][bj] = rd ? *(const u32x4*)(sb + (((ai) * 4 + m) * 2 + bj) * 8192 + so) : (u32x4){0u, 0u, 0u, 0u}; } } while (0)
#define EM_MATH(ai, dst) do { _Pragma("unroll") for (int m = 0; m < 4; ++m) _Pragma("unroll") for (int bj = 0; bj < 2; ++bj) { const u32x4 g_ = gg[m][bj], s_ = ms[m][bj]; const f32x4 v0 = acc[ai][bj][m][0], v1 = acc[ai][bj][m][1]; u32x4 w_; \
            w_.x = pk2(bflo(s_.x) + bflo(g_.x) * v0[0], bfhi(s_.x) + bfhi(g_.x) * v0[1]); w_.y = pk2(bflo(s_.y) + bflo(g_.y) * v0[2], bfhi(s_.y) + bfhi(g_.y) * v0[3]); \
            w_.z = pk2(bflo(s_.z) + bflo(g_.z) * v1[0], bfhi(s_.z) + bfhi(g_.z) * v1[1]); w_.w = pk2(bflo(s_.w) + bflo(g_.w) * v1[2], bfhi(s_.w) + bfhi(g_.w) * v1[3]); dst[m][bj] = w_; } } while (0)
#define EM_STORE(ai, src) do { _Pragma("unroll") for (int m = 0; m < 4; ++m) _Pragma("unroll") for (int bj = 0; bj < 2; ++bj) { \
            if (fin) *(u32x4*)(ub + ((size_t)((ai) * 128 + m * 16) * D + bj * 128) * 2 + uo) = src[m][bj]; else *(u32x4*)(sb + (((ai) * 4 + m) * 2 + bj) * 8192 + so) = src[m][bj]; } } while (0)
        u32x4 w0[4][2];
        EM_LOAD(0);
        EM_MATH(0, w0);
#pragma unroll
        for (int m = 0; m < 4; ++m) asm volatile("" : "+v"(w0[m][0]), "+v"(w0[m][1]));
        asm volatile("" ::: "memory");
        EM_LOAD(1);
        asm volatile("" ::: "memory");
        EM_STORE(0, w0);
        EM_MATH(1, w0);
        EM_STORE(1, w0);
#undef EM_LOAD
#undef EM_MATH
#undef EM_STORE
    }
};

#define XB_TMO      128
#define XB_XCNT(j)  (256  + 64 * (j))
#define XB_XSUB(j)  (1280 + 64 * (j))
#define XB_XGEN(j)  (2304 + 64 * (j))
#define XB_TOP      3328
#define XB_TOPGEN   3392
#define XCD_BAR_WORDS 3456
#define XB_SPIN_CAP (1u << 20)
__device__ __forceinline__ unsigned xb_ld(unsigned* p)              { return __hip_atomic_load(p, __ATOMIC_RELAXED, __HIP_MEMORY_SCOPE_AGENT); }
__device__ __forceinline__ unsigned xb_add(unsigned* p, unsigned v) { return __hip_atomic_fetch_add(p, v, __ATOMIC_RELAXED, __HIP_MEMORY_SCOPE_AGENT); }
__device__ __forceinline__ unsigned xb_xcc_id() { return (unsigned)__builtin_amdgcn_s_getreg((3 << 11) | 20) & 0xFu; }
#define XB_SPIN(cond, bar) do { unsigned _sp = 0; while (cond) { __builtin_amdgcn_s_sleep(1); \
    if ((++_sp & 255u) == 0u) { if (xb_ld(&(bar)[XB_TMO])) break; if (_sp > XB_SPIN_CAP) { atomicAdd(&(bar)[XB_TMO], 1u); break; } } } } while (0)
struct XcdBarrier { unsigned* bar; unsigned x; volatile LAS unsigned* st; };
__device__ __forceinline__ XcdBarrier xcd_barrier_post(unsigned* bar, volatile LAS unsigned* st) {
    XcdBarrier b; b.bar = bar; b.x = xb_xcc_id(); b.st = st;
    if (threadIdx.x == 0) (void)xb_add(&bar[XB_XCNT(b.x)], 1u);
    return b;
}
__device__ __forceinline__ void xcd_barrier_complete(unsigned* bar, unsigned x, unsigned& nloc, unsigned& nx) {
    const unsigned G = gridDim.x * gridDim.y * gridDim.z;
    unsigned sum, cnt, mine, sp = 0u;
    for (;;) {
        sum = 0u; cnt = 0u; mine = 0u;
#pragma unroll
        for (unsigned j = 0; j < 16; ++j) { const unsigned c = xb_ld(&bar[XB_XCNT(j)]); sum += c; cnt += (c > 0u) ? 1u : 0u; mine = (j == x) ? c : mine; }
        if (sum == G) break;
        __builtin_amdgcn_s_sleep(1);
        if ((++sp & 255u) == 0u) { if (xb_ld(&bar[XB_TMO])) break; if (sp > XB_SPIN_CAP) { atomicAdd(&bar[XB_TMO], 1u); break; } }
    }
    nloc = mine > 0u ? mine : 1u; nx = cnt > 0u ? cnt : 1u;
}
__device__ __forceinline__ void xcd_barrier(const XcdBarrier& b) {
    asm volatile("s_waitcnt vmcnt(0)" ::: "memory");
    __syncthreads();
    if (threadIdx.x == 0) {
        unsigned* bar = b.bar;
        __builtin_amdgcn_s_waitcnt(0);
        unsigned nloc = b.st[0], nx = b.st[1];
        if (nloc == 0u) { xcd_barrier_complete(bar, b.x, nloc, nx); b.st[0] = nloc; b.st[1] = nx; }
        const unsigned old = xb_add(&bar[XB_XSUB(b.x)], 1u);
        const unsigned gen = old / nloc;
        if (old + 1u == (gen + 1u) * nloc) {
            __builtin_amdgcn_fence(__ATOMIC_RELEASE, "agent");
            asm volatile("s_waitcnt vmcnt(0)" ::: "memory");
            const unsigned og = xb_add(&bar[XB_TOP], 1u);
            const unsigned tg = og / nx;
            if (og + 1u == (tg + 1u) * nx) xb_add(&bar[XB_TOPGEN], 1u);
            else XB_SPIN(xb_ld(&bar[XB_TOPGEN]) == tg, bar);
            __builtin_amdgcn_fence(__ATOMIC_ACQUIRE, "agent");
            xb_add(&bar[XB_XGEN(b.x)], 1u);
            asm volatile("s_waitcnt vmcnt(0)" ::: "memory");
        } else {
            XB_SPIN(xb_ld(&bar[XB_XGEN(b.x)]) == gen, bar);
            __builtin_amdgcn_fence(__ATOMIC_ACQUIRE, "agent");
            asm volatile("s_waitcnt vmcnt(0)" ::: "memory");
        }
    }
    __syncthreads();
}

constexpr int NWAVES = 8, NTHR = 512;
constexpr int LDS_BYTES = 155648;
constexpr int MISC_OFF = LDS_BYTES - 256;
constexpr int NPH = 29;

struct Args { const float* in[29]; float* out; unsigned char* ws; int ph_lo, ph_hi, use_bar, pad; };
enum { I_X = 0, I_C, I_CTX, I_CCTX, I_WADA, I_BADA, I_F1IN, I_F1OUT, I_F2IN, I_F2OUT, I_WIN, I_S5ARE, I_S5AIM, I_S5DT, I_S5BRE, I_S5BIM, I_S5CRE, I_S5CIM, I_S5D, I_S5WGLU, I_S5BGLU,
       I_CONVW, I_POOLW, I_POOLS, I_MGB, I_MNG, I_WBR, I_WOUT, I_FG };

struct Frame {
    LAS unsigned char* lds;
    int tid, lane, wave, G, gw, NGW;
    unsigned char* ws;
};

constexpr int ADA_KC = 16, ADA_NC = NADA / 256, ADA_ITEMS = NL * ADA_KC * ADA_NC;
__device__ __forceinline__ void p0_ada_item(const Frame& F, const Args& a, int it) {
    const int l = it / (ADA_KC * ADA_NC), r = it % (ADA_KC * ADA_NC), kc = r / ADA_NC, nc = r % ADA_NC, k0 = kc * (D / ADA_KC), col = nc * 256 + 4 * F.lane;
    const float* W = a.in[I_WADA] + ((size_t)l * D + k0) * NADA + col;
    f32x4 a0 = {0.f, 0.f, 0.f, 0.f}, a1 = a0, a2 = a0;
#pragma unroll 1
    for (int j = 0; j < 4; ++j) {
        const int k = k0 + 64 * j + F.lane;
        const float x0 = a.in[I_C][k], x1 = a.in[I_C][D + k], x2 = a.in[I_CCTX][k];
        const float s0 = x0 / (1.f + expf(-x0)), s1 = x1 / (1.f + expf(-x1)), s2 = x2 / (1.f + expf(-x2));
#pragma unroll
        for (int kb = 0; kb < 64; kb += 16) {
            f32x4 w[16];
#pragma unroll
            for (int u = 0; u < 16; ++u) w[u] = __builtin_nontemporal_load((const f32x4*)(W + (size_t)(64 * j + kb + u) * NADA));
#pragma unroll
            for (int u = 0; u < 16; ++u) { const float b0 = __int_as_float(__builtin_amdgcn_readlane(__float_as_int(s0), kb + u)), b1 = __int_as_float(__builtin_amdgcn_readlane(__float_as_int(s1), kb + u)), b2 = __int_as_float(__builtin_amdgcn_readlane(__float_as_int(s2), kb + u));
                a0 += w[u] * b0; a1 += w[u] * b1; a2 += w[u] * b2; }
        }
    }
    float* P = (float*)(F.ws + WS_ADAP) + (((size_t)l * ADA_KC + kc) * 3) * NADA + col;
    *(f32x4*)P = a0; *(f32x4*)(P + NADA) = a1; *(f32x4*)(P + 2 * NADA) = a2;
}
__device__ __forceinline__ void p0_ada_reduce(const Frame& F, const Args& a, int l0, int l1) {
    float* MOD = (float*)(F.ws + WS_MOD); const float* P = (const float*)(F.ws + WS_ADAP);
    for (int i = l0 * 3 * (NADA / 4) + blockIdx.x * NTHR + F.tid; i < l1 * 3 * (NADA / 4); i += F.G * NTHR) {
        const int l = i / (3 * (NADA / 4)), r = i % (3 * (NADA / 4)), v = r / (NADA / 4), c4 = (r % (NADA / 4)) * 4;
        f32x4 s = *(const f32x4*)(a.in[I_BADA] + (size_t)l * NADA + c4);
#pragma unroll
        for (int kc = 0; kc < ADA_KC; ++kc) s += *(const f32x4*)(P + (((size_t)l * ADA_KC + kc) * 3 + v) * NADA + c4);
        *(f32x4*)(MOD + ((size_t)l * 3 + v) * NADA + c4) = s;
    }
}

__device__ __forceinline__ int dst_row(int n, int mode) {
    if (mode == 1) { const int half = n >= DFF ? 1 : 0, jj = n - half * DFF; return 256 * (jj >> 7) + 128 * half + (jj & 127); }
    if (mode == 2) { return n < ZW ? n : (n < ZW + 16 ? (ZW + GW) + (n - ZW) : n - 16); }
    return n;
}
__device__ __forceinline__ void p0_transpose_item(const float* W, int K, int N, bf16_t* WT, int ldd, int mode, LAS unsigned* Lt, int item, int lane) {
    const int nblk = (N + 127) / 128, kb = item / nblk, nb = item % nblk, k0 = 64 * kb, n0 = 128 * nb;
    const int hl = lane >> 5, ln = lane & 31, ncol = n0 + 4 * ln; const bool ok = ncol < N;
#pragma unroll
    for (int hf = 0; hf < 2; ++hf) {
        f32x4 r0[8], r1[8];
#pragma unroll
        for (int i = 0; i < 8; ++i) { const int pp = 2 * (hf * 8 + i) + hl; const float* p = W + (size_t)(k0 + 2 * pp) * N + ncol;
            r0[i] = ok ? __builtin_nontemporal_load((const f32x4*)p) : (f32x4){0.f, 0.f, 0.f, 0.f}; r1[i] = ok ? __builtin_nontemporal_load((const f32x4*)(p + N)) : (f32x4){0.f, 0.f, 0.f, 0.f}; }
#pragma unroll
        for (int i = 0; i < 8; ++i) { const int pp = 2 * (hf * 8 + i) + hl;
#pragma unroll
            for (int e = 0; e < 4; ++e) Lt[(4 * ln + e) * 33 + pp] = pk2(r0[i][e], r1[i][e]); }
    }
    LDS_WAIT();
#pragma unroll 4
    for (int j = 0; j < 16; ++j) { const int q = j * 64 + lane, nrow = q >> 3, kc = q & 7; const LAS unsigned* s = Lt + nrow * 33 + 4 * kc;
        u32x4 o; o.x = s[0]; o.y = s[1]; o.z = s[2]; o.w = s[3];
        if (n0 + nrow < N) __builtin_nontemporal_store(o, (u32x4*)(WT + (size_t)dst_row(n0 + nrow, mode) * ldd + k0 + 8 * kc)); }
    LDS_WAIT();
}
constexpr int I_FIN = (D / 64) * (2 * DFF / 128), I_FOUT = (DFF / 64) * (D / 128), I_IN = (D / 64) * ((NIN + 127) / 128), I_GLU = (BW / 64) * (BW / 128),
              I_PW = (256 / 64) * (256 / 128), I_BRI = (BW / 64) * (D / 128), I_OUT = (D / 64) * (D / 128);
constexpr int PER_L = 2 * I_FIN + 2 * I_FOUT + I_IN + I_GLU + 4 * I_PW + 4 * I_BRI + I_OUT;
__device__ __forceinline__ void p0_tr_item(const Frame& F, const Args& a, int l, int r, LAS unsigned* Lt) {
    if (r < I_FIN) { p0_transpose_item(a.in[I_F1IN] + (size_t)l * D * 2 * DFF, D, 2 * DFF, (bf16_t*)(F.ws + WS_W1IN + (size_t)(l * 2 + 0) * SZ_WFIN), D, 1, Lt, r, F.lane); return; } r -= I_FIN;
    if (r < I_FIN) { p0_transpose_item(a.in[I_F2IN] + (size_t)l * D * 2 * DFF, D, 2 * DFF, (bf16_t*)(F.ws + WS_W1IN + (size_t)(l * 2 + 1) * SZ_WFIN), D, 1, Lt, r, F.lane); return; } r -= I_FIN;
    if (r < I_FOUT) { p0_transpose_item(a.in[I_F1OUT] + (size_t)l * DFF * D, DFF, D, (bf16_t*)(F.ws + WS_W1OUT + (size_t)(l * 2 + 0) * SZ_WFOUT), DFF, 0, Lt, r, F.lane); return; } r -= I_FOUT;
    if (r < I_FOUT) { p0_transpose_item(a.in[I_F2OUT] + (size_t)l * DFF * D, DFF, D, (bf16_t*)(F.ws + WS_W1OUT + (size_t)(l * 2 + 1) * SZ_WFOUT), DFF, 0, Lt, r, F.lane); return; } r -= I_FOUT;
    if (r < I_IN) { p0_transpose_item(a.in[I_WIN] + (size_t)l * D * NIN, D, NIN, (bf16_t*)(F.ws + WS_WIN + (size_t)l * SZ_WIN), D, 2, Lt, r, F.lane); return; } r -= I_IN;
    if (r < I_GLU) { p0_transpose_item(a.in[I_S5WGLU] + (size_t)l * BW * BW, BW, BW, (bf16_t*)(F.ws + WS_WGLU + (size_t)l * SZ_WGLU), BW, 0, Lt, r, F.lane); return; } r -= I_GLU;
    if (r < 4 * I_PW) { const int gi = r / I_PW; p0_transpose_item(a.in[I_POOLW] + ((size_t)l * 4 + gi) * 256 * 256, 256, 256, (bf16_t*)(F.ws + WS_WPOOL + (size_t)l * SZ_WPOOL) + (size_t)gi * 256 * 256, 256, 0, Lt, r % I_PW, F.lane); return; } r -= 4 * I_PW;
    if (r < 4 * I_BRI) { const int bi = r / I_BRI; p0_transpose_item(a.in[I_WBR] + ((size_t)l * 4 + bi) * BW * D, BW, D, (bf16_t*)(F.ws + WS_WBR + (size_t)l * SZ_WSQ) + bi * BW, D, 0, Lt, r % I_BRI, F.lane); return; } r -= 4 * I_BRI;
    p0_transpose_item(a.in[I_WOUT] + (size_t)l * D * D, D, D, (bf16_t*)(F.ws + WS_WOUT + (size_t)l * SZ_WSQ), D, 0, Lt, r, F.lane);
}
constexpr int DEF_L0 = 13312, DEF_TOTAL = DEF_L0 + PER_L, DEF_TAILS = 47040;
__device__ __forceinline__ void deferred_item(const Frame& F, const Args& a, int v, LAS unsigned* Lt) {
    if (v < 2048) { p0_tr_item(F, a, 0, 30944 + v, Lt); return; }
    if (v < 4096) { p0_tr_item(F, a, 0, 32992 + (v - 2048), Lt); return; }
    if (v < 10240) { p0_tr_item(F, a, 0, 6144 + (v - 4096), Lt); return; }
    if (v < DEF_L0) { p0_tr_item(F, a, 0, 15360 + (v - 10240), Lt); return; }
    const int w = v - DEF_L0;
    if (w < 18432) { p0_tr_item(F, a, 1, w, Lt); return; }
    if (w < 22688) { p0_tr_item(F, a, 1, 30784 + (w - 18432), Lt); return; }
    p0_tr_item(F, a, 1, 18432 + (w - 22688), Lt);
}
constexpr int P0_EARLY = 6144 + 3072 + 12512;
constexpr int ADA_L = ADA_ITEMS / NL, SLOT_ITEMS = ADA_L + 3072 + 12512;
__device__ __forceinline__ void p0_transposes(const Frame& F, const Args& a) {
    LAS unsigned* Lt = (LAS unsigned*)(F.lds + F.wave * (128 * 33 * 4));
    for (int it0 = F.gw; it0 < ADA_L + 6144 + (DEF_TOTAL - DEF_TAILS); it0 += F.NGW) {
        if (it0 < ADA_L) { p0_ada_item(F, a, it0); continue; }
        const int j = it0 - ADA_L;
        if (j < 6144) p0_tr_item(F, a, 0, j, Lt);
        else deferred_item(F, a, DEF_TAILS + (j - 6144), Lt);
    }
    for (int l = 0; l < NL; ++l) { u32x4* p = (u32x4*)((bf16_t*)(F.ws + WS_WIN + (size_t)l * SZ_WIN) + (size_t)NIN * D); const int n16 = (NINP - NIN) * D / 8;
        for (int i = blockIdx.x * NTHR + F.tid; i < n16; i += F.G * NTHR) p[i] = (u32x4){0u, 0u, 0u, 0u}; }
}
__device__ __forceinline__ void slot_items(const Frame& F, const Args& a) {
    LAS unsigned* Lt = (LAS unsigned*)(F.lds + F.wave * (128 * 33 * 4));
    for (int s = F.gw; s < SLOT_ITEMS; s += F.NGW) {
        if (s < ADA_L) { p0_ada_item(F, a, ADA_L + s); continue; }
        const int j = s - ADA_L;
        if (j < 3072) p0_tr_item(F, a, 0, 12288 + j, Lt);
        else p0_tr_item(F, a, 0, 18432 + (j - 3072), Lt);
    }
}

__device__ __forceinline__ void tail_items(const Frame& F, const Args& a, int nwg, int lo, int hi) {
    const int r = nwg % F.G; const int c = (int)blockIdx.x;
    if (r == 0 || c < r) return;
    LAS unsigned* Lt = (LAS unsigned*)(F.lds + F.wave * (128 * 33 * 4));
    const int nidle = (F.G - r) * NWAVES;
    for (int it = lo + (c - r) * NWAVES + F.wave; it < hi; it += nidle) deferred_item(F, a, it, Lt);
}

__device__ __forceinline__ void ctx_gates(const Frame& F, int l) {
    if (F.gw >= MC / 16) return;
    const bf16_t* U = (const bf16_t*)(F.ws + WS_U); const bf16_t* Wg = (const bf16_t*)(F.ws + WS_WIN + (size_t)l * SZ_WIN) + (size_t)(ZW + GW) * D; float* GATES = (float*)(F.ws + WS_GATES);
    const int c16 = F.lane & 15, q = F.lane >> 4, row0 = ML + 16 * F.gw;
    const bf16_t* ap = U + (size_t)(row0 + c16) * D + 8 * q; const bf16_t* bp = Wg + (size_t)c16 * D + 8 * q;
    f32x4 acc = {0.f, 0.f, 0.f, 0.f};
#pragma unroll 8
    for (int k = 0; k < D; k += 32) { const bf16x8 af = __builtin_bit_cast(bf16x8, *(const u32x4*)(ap + k)), bf = __builtin_bit_cast(bf16x8, *(const u32x4*)(bp + k));
        acc = __builtin_amdgcn_mfma_f32_16x16x32_bf16(af, bf, acc, 0, 0, 0); }
#pragma unroll
    for (int i = 0; i < 4; ++i) GATES[(size_t)(row0 + 4 * q + i) * 16 + c16] = acc[i];
}

__device__ __forceinline__ void norm_phase(const Frame& F, const Args& a, int l, int si, int nrows, bool first, bool permute) {
    bf16_t* H = (bf16_t*)(F.ws + WS_H); bf16_t* U = (bf16_t*)(F.ws + WS_U);
    const float* MODL = (const float*)(F.ws + WS_MOD) + (size_t)l * 3 * NADA;
    for (int row = F.gw; row < nrows; row += F.NGW) {
        f32x4 v[16]; float ss = 0.f;
        if (first) {
            const f32x4* xr = (const f32x4*)(row < ML ? a.in[I_X] + (size_t)row * D : a.in[I_CTX] + (size_t)(row - ML) * D) + F.lane;
#pragma unroll
            for (int j = 0; j < 16; ++j) v[j] = xr[64 * j];
            u32x2* hw = (u32x2*)(H + (size_t)row * D) + F.lane;
#pragma unroll
            for (int j = 0; j < 16; ++j) { u32x2 w; w.x = pk2(v[j][0], v[j][1]); w.y = pk2(v[j][2], v[j][3]); hw[64 * j] = w; }
        } else {
            const u32x2* hr = (const u32x2*)(H + (size_t)row * D) + F.lane;
#pragma unroll
            for (int j = 0; j < 16; ++j) { const u32x2 w = hr[64 * j]; v[j] = (f32x4){bflo(w.x), bfhi(w.x), bflo(w.y), bfhi(w.y)}; }
        }
#pragma unroll
        for (int j = 0; j < 16; ++j) ss += (v[j][0] * v[j][0] + v[j][1] * v[j][1]) + (v[j][2] * v[j][2] + v[j][3] * v[j][3]);
        const float rstd = 1.f / sqrtf(wave_sum(ss) * (1.f / D) + EPS);
        const float* mv = MODL + (size_t)(row < ML ? (row >> 13) : 2) * NADA;
        const f32x4* sh = (const f32x4*)(mv + (size_t)si * D) + F.lane; const f32x4* sc = (const f32x4*)(mv + (size_t)(si + 1) * D) + F.lane;
        const int orow = permute ? raster2seq(row) : row;
        u32x2* o8 = (u32x2*)(U + (size_t)orow * D) + F.lane;
#pragma unroll
        for (int j = 0; j < 16; ++j) { const f32x4 s = sh[64 * j], c = sc[64 * j]; const f32x4 y = v[j] * rstd * (c + 1.f) + s; u32x2 w; w.x = pk2(y[0], y[1]); w.y = pk2(y[2], y[3]); o8[64 * j] = w; }
    }
}
__device__ __forceinline__ void final_norm_phase(const Frame& F, const Args& a) {
    const bf16_t* H = (const bf16_t*)(F.ws + WS_H);
    for (int row = F.gw; row < ML; row += F.NGW) {
        const u32x2* hr = (const u32x2*)(H + (size_t)row * D) + F.lane; const f32x4* fg = (const f32x4*)a.in[I_FG] + F.lane;
        f32x4 v[16]; float ss = 0.f;
#pragma unroll
        for (int j = 0; j < 16; ++j) { const u32x2 w = hr[64 * j]; v[j] = (f32x4){bflo(w.x), bfhi(w.x), bflo(w.y), bfhi(w.y)}; ss += (v[j][0] * v[j][0] + v[j][1] * v[j][1]) + (v[j][2] * v[j][2] + v[j][3] * v[j][3]); }
        const float rstd = 1.f / sqrtf(wave_sum(ss) * (1.f / D) + EPS);
        f32x4* o = (f32x4*)(a.out + (size_t)row * D) + F.lane;
#pragma unroll
        for (int j = 0; j < 16; ++j) o[64 * j] = v[j] * rstd * fg[64 * j];
    }
}

typedef float f32x16 __attribute__((ext_vector_type(16)));
constexpr int S5_NSEG = 16, S5_SL = (T + CT) / S5_NSEG, S5_NBAT = S5_SL / 16;
constexpr int S5_XPB = 272;
__device__ __forceinline__ int s5_row(int p, int b, int dir) {
    if (p < CT) return ML + b * CT + (dir ? (CT - 1 - p) : p);
    const int q = p - CT; return b * T + (dir ? (T - 1 - q) : q);
}
__device__ __forceinline__ void s5_scan_phase(const Frame& F, const Args& a, int l) {
    const bf16_t* Z = (const bf16_t*)(F.ws + WS_Z); float* YP = (float*)(F.ws + WS_YP);
    LAS float* Es = (LAS float*)F.lds;
    LAS unsigned char* Xl = F.lds + 8192 + F.wave * (32 * S5_XPB);
    const int lane = F.lane, n = lane & 31, h = lane >> 5, w = F.wave;
    for (int unit = blockIdx.x; unit < NB * S5G * 2; unit += F.G) {
        const int b = unit >> 7, g = (unit >> 1) & 63, dir = unit & 1;
        const size_t pb = (((size_t)l * 2 + dir) * S5G + g);
        const float dt = expf(a.in[I_S5DT][pb]);
        float lre[2], lim[2], Lr[2], Li[2]; bf16x8 Bf[4];
#pragma unroll
        for (int e = 0; e < 2; ++e) {
            const int st = n + 32 * e;
            const float are = a.in[I_S5ARE][pb * S5N + st], aim = a.in[I_S5AIM][pb * S5N + st];
            const float mag = expf(dt * are); lre[e] = mag * cosf(dt * aim); lim[e] = mag * sinf(dt * aim);
            const float den = are * are + aim * aim;
            const float zre = ((lre[e] - 1.f) * are + lim[e] * aim) / den, zim = (lim[e] * are - (lre[e] - 1.f) * aim) / den;
            float br[8], bi[8];
#pragma unroll
            for (int c = 0; c < 8; ++c) { const float x = a.in[I_S5BRE][(pb * S5N + st) * S5P + 8 * h + c], y = a.in[I_S5BIM][(pb * S5N + st) * S5P + 8 * h + c]; br[c] = zre * x - zim * y; bi[c] = zre * y + zim * x; }
            u32x4 pr, pi; pr.x = pk2(br[0], br[1]); pr.y = pk2(br[2], br[3]); pr.z = pk2(br[4], br[5]); pr.w = pk2(br[6], br[7]); pi.x = pk2(bi[0], bi[1]); pi.y = pk2(bi[2], bi[3]); pi.z = pk2(bi[4], bi[5]); pi.w = pk2(bi[6], bi[7]);
            Bf[e] = __builtin_bit_cast(bf16x8, pr); Bf[2 + e] = __builtin_bit_cast(bf16x8, pi);
            float pr_ = lre[e], pi_ = lim[e], q16r = 0.f, q16i = 0.f;
#pragma unroll
            for (int s = 0; s < 9; ++s) { const float t = pr_ * pr_ - pi_ * pi_; pi_ = 2.f * pr_ * pi_; pr_ = t; if (s == 3) { q16r = pr_; q16i = pi_; } }
            Lr[e] = pr_ * q16r - pi_ * q16i; Li[e] = pr_ * q16i + pi_ * q16r;
        }
        bf16x8 Cf[4];
        { const int ch = lane & 15, q = lane >> 4;
#pragma unroll
          for (int s = 0; s < 4; ++s) { float cv[8];
#pragma unroll
              for (int c = 0; c < 8; ++c) { const int k = 32 * s + 8 * q + c, np = k >> 2, cc = k & 3, st = np + 32 * (cc & 1);
                  cv[c] = (cc >> 1) ? -a.in[I_S5CIM][(pb * S5P + ch) * S5N + st] : a.in[I_S5CRE][(pb * S5P + ch) * S5N + st]; }
              u32x4 p; p.x = pk2(cv[0], cv[1]); p.y = pk2(cv[2], cv[3]); p.z = pk2(cv[4], cv[5]); p.w = pk2(cv[6], cv[7]); Cf[s] = __builtin_bit_cast(bf16x8, p); } }
        const int r = lane & 31, hr = (r >> 2) & 1, ir = (r & 3) + 4 * (r >> 3);
        const int pa0 = (2 * w + hr) * S5_SL + ir;
        const bf16_t* zcol = Z + ZC_S5 + g * 16 + 8 * h;
        const int seg = 2 * w + h;
        float x0r = 0.f, x0i = 0.f, x1r = 0.f, x1i = 0.f;
        for (int pass = 0; pass < 2; ++pass) {
            if (pass == 1) {
                __syncthreads();
                *(LAS f32x2*)(Es + (seg * 64 + n) * 2) = (f32x2){x0r, x0i}; *(LAS f32x2*)(Es + (seg * 64 + n + 32) * 2) = (f32x2){x1r, x1i};
                __syncthreads();
                float c0r = 0.f, c0i = 0.f, c1r = 0.f, c1i = 0.f;
                for (int s = 0; s < seg; ++s) { const f32x2 e0 = *(const LAS f32x2*)(Es + (s * 64 + n) * 2), e1 = *(const LAS f32x2*)(Es + (s * 64 + n + 32) * 2);
                    float t = Lr[0] * c0r - Li[0] * c0i + e0[0]; c0i = Lr[0] * c0i + Li[0] * c0r + e0[1]; c0r = t;
                    t = Lr[1] * c1r - Li[1] * c1i + e1[0]; c1i = Lr[1] * c1i + Li[1] * c1r + e1[1]; c1r = t; }
                x0r = c0r; x0i = c0i; x1r = c1r; x1i = c1i;
            }
            u32x4 uq[3];
#pragma unroll
            for (int u = 0; u < 3; ++u) uq[u] = *(const u32x4*)(zcol + (size_t)s5_row(pa0 + 16 * u, b, dir) * ZW);
            for (int bt0 = 0; bt0 < S5_NBAT; bt0 += 3)
#pragma unroll
            for (int u = 0; u < 3; ++u) {
                const int bt = bt0 + u;
                const bf16x8 Af = __builtin_bit_cast(bf16x8, uq[u]);
                if (bt + 3 < S5_NBAT) uq[u] = *(const u32x4*)(zcol + (size_t)s5_row(pa0 + 16 * (bt + 3), b, dir) * ZW);
                f32x16 zero;
#pragma unroll
                for (int i = 0; i < 16; ++i) zero[i] = 0.f;
                const f32x16 a0 = __builtin_amdgcn_mfma_f32_32x32x16_bf16(Af, Bf[0], zero, 0, 0, 0), a1 = __builtin_amdgcn_mfma_f32_32x32x16_bf16(Af, Bf[1], zero, 0, 0, 0);
                const f32x16 a2 = __builtin_amdgcn_mfma_f32_32x32x16_bf16(Af, Bf[2], zero, 0, 0, 0), a3 = __builtin_amdgcn_mfma_f32_32x32x16_bf16(Af, Bf[3], zero, 0, 0, 0);
#pragma unroll
                for (int i = 0; i < 16; ++i) {
                    float t = lre[0] * x0r - lim[0] * x0i + a0[i]; x0i = lre[0] * x0i + lim[0] * x0r + a2[i]; x0r = t;
                    t = lre[1] * x1r - lim[1] * x1i + a1[i]; x1i = lre[1] * x1i + lim[1] * x1r + a3[i]; x1r = t;
                    if (pass == 1) { u32x2 wv; wv.x = pk2(x0r, x1r); wv.y = pk2(x0i, x1i); *(LAS u32x2*)(Xl + (16 * h + i) * S5_XPB + 8 * n) = wv; }
                }
                if (pass == 1) {
                    LDS_WAIT();
#pragma unroll
                    for (int gq = 0; gq < 2; ++gq) {
                        f32x4 d = {0.f, 0.f, 0.f, 0.f};
#pragma unroll
                        for (int s = 0; s < 4; ++s) { const bf16x8 Xf = *(const LAS bf16x8*)(Xl + (16 * gq + (lane & 15)) * S5_XPB + 64 * s + 16 * (lane >> 4)); d = __builtin_amdgcn_mfma_f32_16x16x32_bf16(Cf[s], Xf, d, 0, 0, 0); }
                        const int p = (2 * w + gq) * S5_SL + 16 * bt + (lane & 15);
                        *(f32x4*)(YP + ((size_t)dir * MT + s5_row(p, b, dir)) * BW + g * 16 + 4 * (lane >> 4)) = d;
                    }
                    LDS_WAIT();
                }
            }
        }
    }
    __syncthreads();
}
__device__ __forceinline__ void s5_combine_phase(const Frame& F, const Args& a, int l, int nrows) {
    const bf16_t* Z = (const bf16_t*)(F.ws + WS_Z); const float* YP = (const float*)(F.ws + WS_YP); bf16_t* GS5 = (bf16_t*)(F.ws + WS_GS5);
    const float* dsk = a.in[I_S5D] + (size_t)l * BW;
    const int total = nrows * (BW / 8);
    const int stride = F.G * NTHR; int i = blockIdx.x * NTHR + F.tid;
    if (i >= total) return;
    const int c = (i & 127) * 8;
    const f32x4 d0 = *(const f32x4*)(dsk + c), d1 = *(const f32x4*)(dsk + c + 4);
    u32x4 u = *(const u32x4*)(Z + (size_t)(i >> 7) * ZW + ZC_S5 + c);
    f32x4 ya0 = *(const f32x4*)(YP + (size_t)(i >> 7) * BW + c), ya1 = *(const f32x4*)(YP + (size_t)(i >> 7) * BW + c + 4);
    f32x4 yb0 = *(const f32x4*)(YP + (size_t)(MT + (i >> 7)) * BW + c), yb1 = *(const f32x4*)(YP + (size_t)(MT + (i >> 7)) * BW + c + 4);
    for (; i < total; i += stride) {
        const int row = i >> 7, rn = (i + stride < total ? i + stride : i) >> 7;
        const u32x4 un = *(const u32x4*)(Z + (size_t)rn * ZW + ZC_S5 + c);
        const f32x4 na0 = *(const f32x4*)(YP + (size_t)rn * BW + c), na1 = *(const f32x4*)(YP + (size_t)rn * BW + c + 4);
        const f32x4 nb0 = *(const f32x4*)(YP + (size_t)(MT + rn) * BW + c), nb1 = *(const f32x4*)(YP + (size_t)(MT + rn) * BW + c + 4);
        asm volatile("" ::: "memory");
        f32x4 y0, y1;
        y0[0] = d0[0] * bflo(u.x) + ya0[0] + yb0[0]; y0[1] = d0[1] * bfhi(u.x) + ya0[1] + yb0[1]; y0[2] = d0[2] * bflo(u.y) + ya0[2] + yb0[2]; y0[3] = d0[3] * bfhi(u.y) + ya0[3] + yb0[3];
        y1[0] = d1[0] * bflo(u.z) + ya1[0] + yb1[0]; y1[1] = d1[1] * bfhi(u.z) + ya1[1] + yb1[1]; y1[2] = d1[2] * bflo(u.w) + ya1[2] + yb1[2]; y1[3] = d1[3] * bfhi(u.w) + ya1[3] + yb1[3];
        u32x4 w; w.x = pk2(gelu_tanh(y0[0]), gelu_tanh(y0[1])); w.y = pk2(gelu_tanh(y0[2]), gelu_tanh(y0[3])); w.z = pk2(gelu_tanh(y1[0]), gelu_tanh(y1[1])); w.w = pk2(gelu_tanh(y1[2]), gelu_tanh(y1[3]));
        *(u32x4*)(GS5 + (size_t)row * BW + c) = w;
        u = un; ya0 = na0; ya1 = na1; yb0 = nb0; yb1 = nb1;
    }
}

__device__ __forceinline__ void seq_bounds(int row, int& lo, int& hi) { if (row < ML) { lo = row & ~(T - 1); hi = lo + T; } else { lo = ML + ((row - ML) & ~(CT - 1)); hi = lo + CT; } }
template <int HW>
__device__ __forceinline__ void conv_pool_item(const bf16_t* Z, bf16_t* BR, bf16_t* PL, const float* cw, int row, int c, int lo, int hi) {
    u32x4 hh[3], cc[3], uu[2 * HW];
#pragma unroll
    for (int j = 0; j < 3; ++j) { const int r = row - 1 + j; const bool ok = (r >= lo && r < hi);
        hh[j] = ok ? *(const u32x4*)(Z + (size_t)r * ZW + ZC_CH + c) : (u32x4){0u, 0u, 0u, 0u}; cc[j] = ok ? *(const u32x4*)(Z + (size_t)r * ZW + ZC_CC + c) : (u32x4){0u, 0u, 0u, 0u}; }
    const u32x4 bg = *(const u32x4*)(Z + (size_t)row * ZW + ZC_CB + c);
#pragma unroll
    for (int k = 0; k < 2 * HW; ++k) { const int r = row - HW + k; const bool ok = (r >= lo && r < hi);
        uu[k] = ok ? *(const u32x4*)(Z + (size_t)r * ZW + ZC_PL + c) : (u32x4){0u, 0u, 0u, 0u}; }
    asm volatile("" ::: "memory");
    float y[8];
#pragma unroll
    for (int e = 0; e < 8; ++e) y[e] = 0.f;
#pragma unroll
    for (int j = 0; j < 3; ++j) { const f32x4 w0 = *(const f32x4*)(cw + j * BW + c), w1 = *(const f32x4*)(cw + j * BW + c + 4);
        y[0] += w0[0] * bflo(hh[j].x) * bflo(cc[j].x); y[1] += w0[1] * bfhi(hh[j].x) * bfhi(cc[j].x); y[2] += w0[2] * bflo(hh[j].y) * bflo(cc[j].y); y[3] += w0[3] * bfhi(hh[j].y) * bfhi(cc[j].y);
        y[4] += w1[0] * bflo(hh[j].z) * bflo(cc[j].z); y[5] += w1[1] * bfhi(hh[j].z) * bfhi(cc[j].z); y[6] += w1[2] * bflo(hh[j].w) * bflo(cc[j].w); y[7] += w1[3] * bfhi(hh[j].w) * bfhi(cc[j].w); }
    { u32x4 w;
      w.x = pk2(y[0] * bflo(bg.x), y[1] * bfhi(bg.x)); w.y = pk2(y[2] * bflo(bg.y), y[3] * bfhi(bg.y)); w.z = pk2(y[4] * bflo(bg.z), y[5] * bfhi(bg.z)); w.w = pk2(y[6] * bflo(bg.w), y[7] * bfhi(bg.w));
      *(u32x4*)(BR + (size_t)row * D + 1024 + c) = w; }
    float s[8];
#pragma unroll
    for (int e = 0; e < 8; ++e) s[e] = 0.f;
#pragma unroll
    for (int k = 0; k < 2 * HW; ++k) { s[0] += bflo(uu[k].x); s[1] += bfhi(uu[k].x); s[2] += bflo(uu[k].y); s[3] += bfhi(uu[k].y); s[4] += bflo(uu[k].z); s[5] += bfhi(uu[k].z); s[6] += bflo(uu[k].w); s[7] += bfhi(uu[k].w); }
    const int r0 = (row - HW) < lo ? lo : row - HW, r1 = (row + HW) > hi ? hi : row + HW;
    const float inv = 1.f / (float)(r1 - r0); const u32x4 us = uu[HW]; u32x4 w;
    w.x = pk2(s[0] * inv - bflo(us.x), s[1] * inv - bfhi(us.x)); w.y = pk2(s[2] * inv - bflo(us.y), s[3] * inv - bfhi(us.y));
    w.z = pk2(s[4] * inv - bflo(us.z), s[5] * inv - bfhi(us.z)); w.w = pk2(s[6] * inv - bflo(us.w), s[7] * inv - bfhi(us.w));
    *(u32x4*)(PL + (size_t)row * BW + c) = w;
}
__device__ __forceinline__ void conv_pool_phase(const Frame& F, const Args& a, int l, int nrows) {
    const bf16_t* Z = (const bf16_t*)(F.ws + WS_Z); bf16_t* BR = (bf16_t*)(F.ws + WS_BR); bf16_t* PL = (bf16_t*)(F.ws + WS_PL);
    const float* cw = a.in[I_CONVW] + (size_t)l * 3 * BW;
    const int nitems = (nrows / 2) * 4;
    for (int it = F.gw; it < nitems; it += F.NGW) {
        const int pg = it & 3, row = 2 * (it >> 2) + (F.lane >> 5), c = 256 * pg + 8 * (F.lane & 31); int lo, hi; seq_bounds(row, lo, hi);
        if (pg == 0) conv_pool_item<1>(Z, BR, PL, cw, row, c, lo, hi); else if (pg == 1) conv_pool_item<2>(Z, BR, PL, cw, row, c, lo, hi);
        else if (pg == 2) conv_pool_item<4>(Z, BR, PL, cw, row, c, lo, hi); else conv_pool_item<8>(Z, BR, PL, cw, row, c, lo, hi);
    }
}

__device__ __forceinline__ int ml_chunk_base(int ci, int b, int dir) {
    if (ci < 4) return ML + b * CT + (dir ? 3 - ci : ci) * CHK;
    return b * T + (dir ? 127 - (ci - 4) : ci - 4) * CHK;
}
constexpr int M2_HP = 260;
constexpr int ML_PF = 4;
constexpr int ML_RP = 80;
constexpr int ML_IMGB = 64 * ML_RP;
constexpr int ML_WAVE_BYTES = 2 * ML_IMGB;
__device__ __forceinline__ void mlstm_state_phase(const Frame& F, const Args& a, int l) {
    const bf16_t* Z = (const bf16_t*)(F.ws + WS_Z); const float* GATES = (const float*)(F.ws + WS_GATES);
    bf16_t* CIN = (bf16_t*)(F.ws + WS_CIN); float* NIN = (float*)(F.ws + WS_NIN); float* MIN_ = (float*)(F.ws + WS_MIN);
    LAS unsigned char* img = F.lds + F.wave * ML_WAVE_BYTES;
    LAS float* kwt = (LAS float*)(F.lds + NWAVES * ML_WAVE_BYTES);
    LAS float* gmx = kwt + NCHK * 64;
    LAS float* gbl = gmx + NCHK;
    LAS float* cdv = gbl + NCHK;
    LAS float* mv = cdv + NCHK;
    const float* gb = a.in[I_MGB] + (size_t)l * 16;
    const int lane = F.lane, w = F.wave, q = lane >> 4, c16 = lane & 15;
    for (int unit = blockIdx.x; unit < 256; unit += F.G) {
        const int chain = unit >> 4, sl = unit & 15, b = chain >> 3, h = (chain >> 1) & 3, dir = chain & 1;
        const float bi = gb[dir * 4 + h], bfg = gb[(2 + dir) * 4 + h];
        const bf16_t* kbase = (const bf16_t*)(F.ws + WS_KC) + (size_t)(h * 8 + w) * MT * 16; const bf16_t* vbase = (const bf16_t*)(F.ws + WS_VC) + (size_t)(h * 16 + sl) * MT * 16;
        __syncthreads();
        for (int ci = w; ci < NCHK; ci += NWAVES) {
            const int row_ = ml_chunk_base(ci, b, dir) + (dir ? 63 - lane : lane);
            const float li = GATES[(size_t)row_ * 16 + dir * 4 + h] + bi, lf = logsigmoid(GATES[(size_t)row_ * 16 + (2 + dir) * 4 + h] + bfg);
            float bc = lf;
#pragma unroll
            for (int o = 1; o < 64; o <<= 1) { const float x = __shfl_up(bc, o); if (lane >= o) bc += x; }
            const float av = li - bc, amax = wave_max(av), blast = __shfl(bc, 63);
            kwt[ci * 64 + lane] = av; if (lane == 0) { gmx[ci] = amax; gbl[ci] = blast; }
        }
        __syncthreads();
        if (w == 0) { float m = 0.f;
#pragma unroll 4
            for (int ci = 0; ci < NCHK; ++ci) { const float amax = gmx[ci], bl = gbl[ci]; const float mm = fmaxf(m, amax);
                if (lane == 0) { cdv[ci] = __expf(m - mm); mv[ci] = m; gmx[ci] = mm; }
                m = bl + mm; }
        }
        __syncthreads();
        for (int ci = w; ci < NCHK; ci += NWAVES) kwt[ci * 64 + lane] = __expf(kwt[ci * 64 + lane] - gmx[ci]);
        if (sl == 0 && w == 0) for (int ci = lane; ci < NCHK; ci += 64) MIN_[(size_t)chain * NCHK + ci] = mv[ci];
        __syncthreads();
        f32x4 acc = {0.f, 0.f, 0.f, 0.f}, accn = {0.f, 0.f, 0.f, 0.f};
        u32x4 pk[ML_PF][2], pv[ML_PF][2];
#define ML_LOAD(slot, ci_) do { const int row_ = ml_chunk_base((ci_), b, dir) + (dir ? 63 - lane : lane); const bf16_t* kr_ = kbase + (size_t)row_ * 16; const bf16_t* vr_ = vbase + (size_t)row_ * 16; \
            pk[slot][0] = *(const u32x4*)kr_; pk[slot][1] = *(const u32x4*)(kr_ + 8); pv[slot][0] = *(const u32x4*)vr_; pv[slot][1] = *(const u32x4*)(vr_ + 8); } while (0)
#define ML_SCALE(x4, k_) ((u32x4){pk2(bflo((x4).x) * (k_), bfhi((x4).x) * (k_)), pk2(bflo((x4).y) * (k_), bfhi((x4).y) * (k_)), pk2(bflo((x4).z) * (k_), bfhi((x4).z) * (k_)), pk2(bflo((x4).w) * (k_), bfhi((x4).w) * (k_))})
#define ML_WRITE_IMG(slot, ci_, buf_) do { LAS u32x4* d_ = (LAS u32x4*)(img + (buf_) * ML_IMGB + lane * ML_RP); const float kwj_ = kwt[(ci_) * 64 + lane]; \
            d_[0] = pk[slot][0]; d_[1] = pk[slot][1]; d_[2] = ML_SCALE(pv[slot][0], kwj_); d_[3] = ML_SCALE(pv[slot][1], kwj_); } while (0)
#pragma unroll
        for (int u = 0; u < ML_PF; ++u) ML_LOAD(u, u);
        ML_WRITE_IMG(0, 0, 0); ML_LOAD(0, ML_PF);
        LDS_WAIT();
        for (int c0 = 0; c0 < NCHK; c0 += ML_PF) {
#pragma unroll
            for (int u = 0; u < ML_PF; ++u) {
                const int ci = c0 + u, cur = ci & 1;
                const LAS unsigned char* ib = img + cur * ML_IMGB + (8 * q + (c16 >> 2)) * ML_RP + 8 * (lane & 3);
                typedef short s16x4 __attribute__((ext_vector_type(4)));
#define ML_TR(off_) __builtin_amdgcn_ds_read_tr16_b64_v4i16((LAS s16x4*)(ib + (off_)))
                const s16x4 ka0 = ML_TR(0), ka1 = ML_TR(4 * ML_RP), kb0 = ML_TR(32 * ML_RP), kb1 = ML_TR(36 * ML_RP);
                const s16x4 va0 = ML_TR(32), va1 = ML_TR(4 * ML_RP + 32), vb0 = ML_TR(32 * ML_RP + 32), vb1 = ML_TR(36 * ML_RP + 32);
#undef ML_TR
                const bf16x8 af0 = __builtin_shufflevector(ka0, ka1, 0, 1, 2, 3, 4, 5, 6, 7), af1 = __builtin_shufflevector(kb0, kb1, 0, 1, 2, 3, 4, 5, 6, 7);
                const bf16x8 bf0 = __builtin_shufflevector(va0, va1, 0, 1, 2, 3, 4, 5, 6, 7), bf1 = __builtin_shufflevector(vb0, vb1, 0, 1, 2, 3, 4, 5, 6, 7);
                u32x4 bn0 = {0u, 0u, 0u, 0u}, bn1 = {0u, 0u, 0u, 0u};
                if (sl == 0) { const LAS float* kp = kwt + ci * 64 + 8 * q; const f32x4 k0 = *(const LAS f32x4*)kp, k1 = *(const LAS f32x4*)(kp + 4), k2 = *(const LAS f32x4*)(kp + 32), k3 = *(const LAS f32x4*)(kp + 36);
                    const bool c0l = (c16 == 0);
                    bn0.x = c0l ? pk2(k0[0], k0[1]) : 0u; bn0.y = c0l ? pk2(k0[2], k0[3]) : 0u; bn0.z = c0l ? pk2(k1[0], k1[1]) : 0u; bn0.w = c0l ? pk2(k1[2], k1[3]) : 0u;
                    bn1.x = c0l ? pk2(k2[0], k2[1]) : 0u; bn1.y = c0l ? pk2(k2[2], k2[3]) : 0u; bn1.z = c0l ? pk2(k3[0], k3[1]) : 0u; bn1.w = c0l ? pk2(k3[2], k3[3]) : 0u; }
                const float cd = cdv[ci];
                { u32x2 cw; cw.x = pk2(acc[0], acc[1]); cw.y = pk2(acc[2], acc[3]);
                  *(u32x2*)(CIN + (((size_t)chain * NCHK + ci) * DV + sl * 16 + c16) * DK + 16 * w + 4 * q) = cw; }
                if (sl == 0 && c16 == 0) *(f32x4*)(NIN + ((size_t)chain * NCHK + ci) * DK + 16 * w + 4 * q) = accn;
                if (ci + 1 < NCHK) { ML_WRITE_IMG((u + 1) % ML_PF, ci + 1, cur ^ 1); if (ci + 1 + ML_PF < NCHK) ML_LOAD((u + 1) % ML_PF, ci + 1 + ML_PF); }
                LDS_WAIT();
                acc *= cd; accn *= cd;
                acc = __builtin_amdgcn_mfma_f32_16x16x32_bf16(af0, bf0, acc, 0, 0, 0);
                acc = __builtin_amdgcn_mfma_f32_16x16x32_bf16(af1, bf1, acc, 0, 0, 0);
                if (sl == 0) {
                    accn = __builtin_amdgcn_mfma_f32_16x16x32_bf16(af0, __builtin_bit_cast(bf16x8, bn0), accn, 0, 0, 0);
                    accn = __builtin_amdgcn_mfma_f32_16x16x32_bf16(af1, __builtin_bit_cast(bf16x8, bn1), accn, 0, 0, 0);
                }
            }
        }
#undef ML_LOAD
#undef ML_SCALE
#undef ML_WRITE_IMG
    }
    __syncthreads();
}

constexpr int M2_QP = 272, M2_VP = 144;
__device__ __forceinline__ void mlstm_out_phase(const Frame& F, const Args& a, int l, bool last) {
    const bf16_t* Z = (const bf16_t*)(F.ws + WS_Z); const float* GATES = (const float*)(F.ws + WS_GATES); bf16_t* BR = (bf16_t*)(F.ws + WS_BR);
    const bf16_t* CINT = (const bf16_t*)(F.ws + WS_CIN); const float* NIN = (const float*)(F.ws + WS_NIN); const float* MIN_ = (const float*)(F.ws + WS_MIN);
    LAS unsigned char* Qs = F.lds;
    LAS unsigned char* Ks = Qs + 64 * M2_QP;
    LAS unsigned char* Vt = Ks + 64 * M2_QP + F.wave * (32 * M2_VP);
    LAS unsigned char* Wb = Ks + 64 * M2_QP + 8 * (32 * M2_VP);
    LAS float* Ss = (LAS float*)(Wb + 64 * M2_VP);
    LAS float* vec = Ss + 64 * 65;
    const float* gb = a.in[I_MGB] + (size_t)l * 16;
    const float* gain = a.in[I_MNG] + (size_t)l * BW;
    const float qscale = 0.08838834764831845f;
    const int w = F.wave;
#define M2_IDS int t = F.tid; asm volatile("" : "+v"(t)); const int lane = t & 63, n = lane & 31, hh = lane >> 5; (void)n; (void)hh; (void)lane
    for (int unit = blockIdx.x; unit < NB * HEADS * NCHK; unit += F.G) {
        const int c = unit % NCHK, bh = unit / NCHK, b = bh >> 2, h = bh & 3;
        if (last && c < 4) continue;
        const int base = c < 4 ? ML + b * CT + c * CHK : b * T + (c - 4) * CHK;
        __syncthreads();
        u32x4 og[4];
        float gpre[4] = {0.f, 0.f, 0.f, 0.f}, npre[2] = {0.f, 0.f}, mpre[2];
        const float gbv[4] = {gb[h], gb[8 + h], gb[4 + h], gb[12 + h]};
        { M2_IDS; const u32x4* op = (const u32x4*)(Z + (size_t)(base + (t >> 3)) * ZW + ZC_O + h * DV + 32 * (t & 7));
#pragma unroll
          for (int j = 0; j < 4; ++j) og[j] = op[j];
#pragma unroll
          for (int d2 = 0; d2 < 2; ++d2) { const int chain = (b * 4 + h) * 2 + d2, ci = c < 4 ? (d2 ? 3 - c : c) : 4 + (d2 ? 127 - (c - 4) : c - 4);
              mpre[d2] = MIN_[(size_t)chain * NCHK + ci];
              { const int tg = t & 63; const size_t row = (size_t)(base + (d2 ? 63 - tg : tg)); gpre[2 * d2] = GATES[row * 16 + d2 * 4 + h]; gpre[2 * d2 + 1] = GATES[row * 16 + (2 + d2) * 4 + h]; }
              npre[d2] = NIN[((size_t)chain * NCHK + ci) * DK + ((t - 64) & (DK - 1))]; } }
        { M2_IDS;
        u32x4 qv[2], kv[2], v4[4];
#pragma unroll
        for (int i = 0; i < 2; ++i) { const int q = t + i * NTHR, j = q >> 4, part = q & 15; const size_t ro = (size_t)(base + j) * ZW;
            qv[i] = *(const u32x4*)(Z + ro + ZC_Q + h * DK + part * 8); kv[i] = *(const u32x4*)(Z + ro + ZC_K + h * DK + part * 8); }
        { const bf16_t* vr = Z + (size_t)(base + lane) * ZW + ZC_V + h * DV + 32 * w;
#pragma unroll
          for (int i = 0; i < 4; ++i) v4[i] = *(const u32x4*)(vr + 8 * i); }
        asm volatile("" ::: "memory");
#pragma unroll
        for (int i = 0; i < 2; ++i) { const int q = t + i * NTHR, j = q >> 4, part = q & 15;
            *(LAS u32x4*)(Qs + j * M2_QP + part * 16) = qv[i]; *(LAS u32x4*)(Ks + j * M2_QP + part * 16) = kv[i]; }
        {
#pragma unroll
            for (int i = 0; i < 4; ++i) { const u32x4 vv = v4[i]; LAS bf16_t* d0 = (LAS bf16_t*)(Vt + (8 * i) * M2_VP) + lane;
                d0[0 * (M2_VP / 2)] = (bf16_t)(vv.x & 0xffffu); d0[1 * (M2_VP / 2)] = (bf16_t)(vv.x >> 16); d0[2 * (M2_VP / 2)] = (bf16_t)(vv.y & 0xffffu); d0[3 * (M2_VP / 2)] = (bf16_t)(vv.y >> 16);
                d0[4 * (M2_VP / 2)] = (bf16_t)(vv.z & 0xffffu); d0[5 * (M2_VP / 2)] = (bf16_t)(vv.z >> 16); d0[6 * (M2_VP / 2)] = (bf16_t)(vv.w & 0xffffu); d0[7 * (M2_VP / 2)] = (bf16_t)(vv.w >> 16); }
        }
        }
        __syncthreads();
        if (w < 4) { M2_IDS;
            const int tt = w >> 1, st = w & 1; f32x16 sa;
#pragma unroll
            for (int i = 0; i < 16; ++i) sa[i] = 0.f;
#pragma unroll
            for (int ks = 0; ks < 8; ++ks) { const bf16x8 Af = *(const LAS bf16x8*)(Qs + (32 * tt + n) * M2_QP + 32 * ks + 16 * hh), Bq = *(const LAS bf16x8*)(Ks + (32 * st + n) * M2_QP + 32 * ks + 16 * hh);
                sa = __builtin_amdgcn_mfma_f32_32x32x16_bf16(Af, Bq, sa, 0, 0, 0); }
#pragma unroll
            for (int i = 0; i < 16; ++i) Ss[(32 * tt + (i & 3) + 8 * (i >> 2) + 4 * hh) * 65 + 32 * st + n] = sa[i] * qscale;
        } else if (w < 6) { M2_IDS;
            const int ds = w - 4; LAS float* vd = vec + (ds ? 576 : 0); const float m_in = ds ? mpre[1] : mpre[0];
            const float li = ds ? gpre[2] + gbv[2] : gpre[0] + gbv[0], lf = logsigmoid(ds ? gpre[3] + gbv[3] : gpre[1] + gbv[1]);
            float bc = lf;
#pragma unroll
            for (int o = 1; o < 64; o <<= 1) { const float x = __shfl_up(bc, o); if (lane >= o) bc += x; }
            const float av = li - bc; float pm = av;
#pragma unroll
            for (int o = 1; o < 64; o <<= 1) { const float x = __shfl_up(pm, o); if (lane >= o) pm = fmaxf(pm, x); }
            const float mx = fmaxf(pm, m_in), mt = bc + mx;
            vd[lane] = bc; vd[64 + lane] = av; vd[128 + lane] = mt; vd[192 + lane] = __expf(m_in - mx); vd[256 + lane] = __expf(-mt);
        } else { M2_IDS; const int k = (t - 64) & (DK - 1); vec[448 + k] = npre[0]; vec[896 + k] = npre[1]; }
        bf16x8 Vf[4];
        { M2_IDS;
#pragma unroll
        for (int ks = 0; ks < 4; ++ks) Vf[ks] = *(const LAS bf16x8*)(Vt + n * M2_VP + 32 * ks + 16 * hh); }
        f32x16 hs[2];
#pragma unroll
        for (int i = 0; i < 16; ++i) { hs[0][i] = 0.f; hs[1][i] = 0.f; }
#pragma nounroll
        for (int dir_ = 0; dir_ < 2; ++dir_) {
            int dir = dir_; asm volatile("" : "+s"(dir));
            const int chain = (b * 4 + h) * 2 + dir;
            const int ci = c < 4 ? (dir ? 3 - c : c) : 4 + (dir ? 127 - (c - 4) : c - 4);
            bf16x8 Cf[8];
            { M2_IDS; const bf16_t* cp = CINT + (((size_t)chain * NCHK + ci) * DV + 32 * w + n) * DK + 8 * hh;
#pragma unroll
              for (int ks = 0; ks < 8; ++ks) Cf[ks] = __builtin_bit_cast(bf16x8, *(const u32x4*)(cp + 16 * ks)); }
            __syncthreads();
            {   M2_IDS;
                const LAS float* vd = vec + (dir ? 576 : 0); const LAS float* nd = vec + (dir ? 896 : 448);
                const int tm = t >> 3, part = t & 7, j = dir ? 63 - tm : tm; const float bj = vd[j] - vd[128 + j];
                float wv[8], s = 0.f;
#pragma unroll
                for (int e = 0; e < 8; ++e) { const int sm = 8 * part + e, i = dir ? 63 - sm : sm; wv[e] = (i <= j) ? Ss[tm * 65 + sm] * __expf(bj + vd[64 + i]) : 0.f; s += wv[e]; }
                u32x4 pw; pw.x = pk2(wv[0], wv[1]); pw.y = pk2(wv[2], wv[3]); pw.z = pk2(wv[4], wv[5]); pw.w = pk2(wv[6], wv[7]);
                *(LAS u32x4*)(Wb + tm * M2_VP + 16 * part) = pw;
                float qn = 0.f; const LAS bf16_t* qr = (const LAS bf16_t*)(Qs + tm * M2_QP) + part * 16;
#pragma unroll
                for (int dd = 0; dd < 16; ++dd) qn += bf1(qr[dd]) * nd[part * 16 + dd];
                s += vd[192 + j] * qscale * qn;
                s += __shfl_xor(s, 1); s += __shfl_xor(s, 2); s += __shfl_xor(s, 4);
                if (part == 0) { const float inv = 1.f / fmaxf(fabsf(s), vd[256 + j]); vec[320 + tm] = inv; vec[384 + tm] = vd[192 + j] * qscale * inv; }
            }
            __syncthreads();
            { M2_IDS;
#pragma unroll
            for (int tt = 0; tt < 2; ++tt) {
                f32x16 n1, n2;
#pragma unroll
                for (int i = 0; i < 16; ++i) { n1[i] = 0.f; n2[i] = 0.f; }
#pragma unroll
                for (int ks = 0; ks < 4; ++ks) { const bf16x8 Af = *(const LAS bf16x8*)(Wb + (32 * tt + n) * M2_VP + 32 * ks + 16 * hh); n1 = __builtin_amdgcn_mfma_f32_32x32x16_bf16(Af, Vf[ks], n1, 0, 0, 0); }
                asm volatile("" ::: "memory");
#pragma unroll
                for (int ks = 0; ks < 8; ++ks) { const bf16x8 Af = *(const LAS bf16x8*)(Qs + (32 * tt + n) * M2_QP + 32 * ks + 16 * hh); n2 = __builtin_amdgcn_mfma_f32_32x32x16_bf16(Af, Cf[ks], n2, 0, 0, 0);
                    if (ks == 3) asm volatile("" ::: "memory"); }
                asm volatile("" ::: "memory");
#pragma unroll
                for (int i = 0; i < 16; ++i) { const int tm = 32 * tt + (i & 3) + 8 * (i >> 2) + 4 * hh; hs[tt][i] += n1[i] * vec[320 + tm] + n2[i] * vec[384 + tm]; }
                asm volatile("" ::: "memory");
            }
            }
        }
        __syncthreads();
        { M2_IDS; LAS float* HS = (LAS float*)F.lds;
#pragma unroll
          for (int tt = 0; tt < 2; ++tt)
#pragma unroll
            for (int i = 0; i < 16; ++i) HS[(32 * tt + (i & 3) + 8 * (i >> 2) + 4 * hh) * M2_HP + 32 * w + n] = hs[tt][i];
        }
        __syncthreads();
        { M2_IDS; const int tm = t >> 3, part = t & 7;
          const LAS f32x4* hr = (const LAS f32x4*)((const LAS float*)F.lds + tm * M2_HP + 32 * part);
          const f32x4* gp = (const f32x4*)(gain + h * DV + 32 * part);
          f32x4 x[8], gq[8]; float s = 0.f;
#pragma unroll
          for (int j = 0; j < 8; ++j) { x[j] = hr[j]; gq[j] = gp[j]; }
#pragma unroll
          for (int j = 0; j < 8; ++j) s += (x[j][0] * x[j][0] + x[j][1] * x[j][1]) + (x[j][2] * x[j][2] + x[j][3] * x[j][3]);
          s += __shfl_xor(s, 1); s += __shfl_xor(s, 2); s += __shfl_xor(s, 4);
          const float rs = 1.f / sqrtf(s * (1.f / DV) + EPS);
          bf16_t* bo = BR + (size_t)(base + tm) * D + 3072 + h * DV + 32 * part;
#pragma unroll
          for (int j = 0; j < 4; ++j) { const u32x4 o = og[j]; const f32x4 a0 = x[2 * j] * gq[2 * j] * rs, a1 = x[2 * j + 1] * gq[2 * j + 1] * rs; u32x4 pw;
              pw.x = pk2(a0[0] * sigm(bflo(o.x)), a0[1] * sigm(bfhi(o.x))); pw.y = pk2(a0[2] * sigm(bflo(o.y)), a0[3] * sigm(bfhi(o.y)));
              pw.z = pk2(a1[0] * sigm(bflo(o.z)), a1[1] * sigm(bfhi(o.z))); pw.w = pk2(a1[2] * sigm(bflo(o.w)), a1[3] * sigm(bfhi(o.w)));
              *(u32x4*)(bo + 8 * j) = pw; }
        }
    }
    __syncthreads();
#undef M2_IDS
}

__device__ __forceinline__ unsigned char* launder(unsigned char* p) { unsigned long long v = (unsigned long long)p; asm volatile("" : "+s"(v)); return (unsigned char*)(gchar_t*)v; }
__device__ __forceinline__ Frame make_frame(unsigned char* ws, LAS unsigned char* lds) {
    Frame F; F.lds = lds; { int t_ = threadIdx.x; asm volatile("" : "+v"(t_)); F.tid = t_; } F.lane = F.tid & 63; F.wave = __builtin_amdgcn_readfirstlane(F.tid >> 6);
    { int g_ = gridDim.x; asm volatile("" : "+s"(g_)); F.G = g_; } F.gw = blockIdx.x * NWAVES + F.wave; F.NGW = F.G * NWAVES; F.ws = ws; return F;
}
__global__ void __launch_bounds__(NTHR, 2) fwd_kernel(Args args) {
    extern __shared__ __attribute__((aligned(16))) unsigned char lds_raw[];
    LAS unsigned char* const lds = (LAS unsigned char*)lds_raw;
    { volatile LAS unsigned* MISC = (volatile LAS unsigned*)(lds + MISC_OFF);
      if (threadIdx.x < 64) MISC[threadIdx.x] = 0u;
      __syncthreads();
      if (args.use_bar) (void)xcd_barrier_post((unsigned*)(args.ws + WS_CTL), MISC + 8); }
    const int lo = args.ph_lo, hi = args.ph_hi;
#ifndef PH_EN
#define PH_EN 0xffff
#endif
#define IN(k) (lo <= (k) && (k) < hi)
#define EN(j) (((PH_EN) >> (j)) & 1)
#define SEAM(k) do { if (args.use_bar && IN((k) + 1)) { XcdBarrier b_; b_.bar = (unsigned*)(launder(args.ws) + WS_CTL); b_.x = xb_xcc_id(); b_.st = (volatile LAS unsigned*)(lds + MISC_OFF) + 8; xcd_barrier(b_); } } while (0)
#define PHASE_BEGIN unsigned char* ws = launder(args.ws); const Frame F = make_frame(ws, lds); (void)F
#define RUN_GEMM(EpiT, E, Aptr, Bptr, lda_, ldb_, K_, apn_, nM_, nN_) do { int k_ = (K_); asm volatile("" : "+s"(k_)); pg8::Gemm g_{(const bf16_t*)(Aptr), (const bf16_t*)(Bptr), (lda_), (ldb_), k_, (apn_)}; \
        pg8::StaticOrder S_; { int g2_ = gridDim.x, c2_ = blockIdx.x; asm volatile("" : "+s"(g2_), "+s"(c2_)); S_.init((nM_), (nN_), g2_, c2_); } pg8::gemm_phase<EpiT>(lds, g_, S_, E); } while (0)

    if (EN(13) && IN(0)) { PHASE_BEGIN; p0_transposes(F, args); SEAM(0); }
    if (EN(13) && IN(1)) { PHASE_BEGIN; p0_ada_reduce(F, args, 0, 1); SEAM(1); }

    for (int l = 0; l < NL; ++l) {
        const int pb = 2 + 13 * l;
#define LASTL (l == NL - 1)
#define NMO (LASTL ? 64 : 66)
#define NRO (LASTL ? ML : MT)
#define MODL ((const float*)(ws + WS_MOD) + (size_t)l * 3 * NADA)
        if (EN(0) && IN(pb + 0)) { PHASE_BEGIN; norm_phase(F, args, l, 0, MT, l == 0, false); SEAM(pb + 0); }
        if (EN(1) && IN(pb + 1)) { PHASE_BEGIN; EpiSwiglu E{(bf16_t*)(ws + WS_HID)};
            if (l == 0) { int k_ = D; asm volatile("" : "+s"(k_)); pg8::Gemm g_{(const bf16_t*)(ws + WS_U), (const bf16_t*)(ws + WS_W1IN), D, D, k_, 0};
                pg8::StaticOrder S_; { int g2_ = gridDim.x, c2_ = blockIdx.x; asm volatile("" : "+s"(g2_), "+s"(c2_)); S_.init(66, 48, g2_, c2_); }
                const int x_ = (S_.c & 7) + 1;
                S_.i1 = x_; pg8::gemm_phase<EpiSwiglu>(lds, g_, S_, E);
                slot_items(F, args); __syncthreads();
                S_.i0 = x_; S_.i1 = 0x7fffffff; pg8::gemm_phase<EpiSwiglu>(lds, g_, S_, E); }
            else RUN_GEMM(EpiSwiglu, E, ws + WS_U, ws + WS_W1IN + (size_t)(l * 2 + 0) * SZ_WFIN, D, D, D, 0, 66, 48);
            tail_items(F, args, 3168, l == 0 ? 0 : 35040, l == 0 ? 3300 : 38340); SEAM(pb + 1); }
        if (EN(2) && IN(pb + 2)) { PHASE_BEGIN; EpiResid E{(bf16_t*)(ws + WS_H), MODL + 2 * D, 0.5f, 0}; RUN_GEMM(EpiResid, E, ws + WS_HID, ws + WS_W1OUT + (size_t)(l * 2 + 0) * SZ_WFOUT, HIDP, DFF, DFF, 0, 66, 16); tail_items(F, args, 1056, l == 0 ? 3300 : 38340, l == 0 ? 12000 : 47040); SEAM(pb + 2); }
        if (EN(3) && IN(pb + 3)) { PHASE_BEGIN; norm_phase(F, args, l, 3, MT, false, (l & 1) != 0); if (l == 0) p0_ada_reduce(F, args, 1, NL); SEAM(pb + 3); }
        if (EN(4) && IN(pb + 4)) { PHASE_BEGIN; EpiWin E{(bf16_t*)(ws + WS_Z), (bf16_t*)(ws + WS_G), (float*)(ws + WS_GATES), (bf16_t*)(ws + WS_KC), (bf16_t*)(ws + WS_VC)}; { int k_ = D; asm volatile("" : "+s"(k_)); pg8::Gemm g_{(const bf16_t*)(ws + WS_U), (const bf16_t*)(ws + WS_WIN + (size_t)l * SZ_WIN), D, D, k_, 0};
              pg8::StaticOrder S_; { int g2_ = gridDim.x, c2_ = blockIdx.x; asm volatile("" : "+s"(g2_), "+s"(c2_)); S_.init(64, 97, g2_, c2_); } S_.add_extra(2, LASTL ? 32 : 96);
              pg8::gemm_phase<EpiWin>(lds, g_, S_, E); }
            ctx_gates(F, l); SEAM(pb + 4); }
        if (EN(5) && IN(pb + 5)) {
            { PHASE_BEGIN; s5_scan_phase(F, args, l); }
            { PHASE_BEGIN; mlstm_state_phase(F, args, l); }
            { PHASE_BEGIN; conv_pool_phase(F, args, l, NRO); }
            SEAM(pb + 5); }
        if (EN(6) && IN(pb + 6)) {
            { PHASE_BEGIN; s5_combine_phase(F, args, l, NRO); }
            { PHASE_BEGIN; mlstm_out_phase(F, args, l, LASTL); }
            SEAM(pb + 6); }
        if (EN(7) && IN(pb + 7)) {
            { PHASE_BEGIN; EpiGlu E{(const bf16_t*)(ws + WS_GS5), (bf16_t*)(ws + WS_BR), args.in[I_S5BGLU] + (size_t)l * BW}; RUN_GEMM(EpiGlu, E, ws + WS_GS5, ws + WS_WGLU + (size_t)l * SZ_WGLU, BW, BW, BW, 0, NMO, 4); }
            { PHASE_BEGIN; EpiPool E{(bf16_t*)(ws + WS_BR), args.in[I_POOLS] + (size_t)l * BW}; RUN_GEMM(EpiPool, E, ws + WS_PL, ws + WS_WPOOL + (size_t)l * SZ_WPOOL, BW, 256, 256, 256, NMO, 4); }
            SEAM(pb + 7); }
        if (EN(8) && IN(pb + 8)) { PHASE_BEGIN; EpiMerge2 E{(const bf16_t*)(ws + WS_G), (bf16_t*)(ws + WS_U), nullptr}; { int k_ = BW; asm volatile("" : "+s"(k_)); pg8::Gemm g_{(const bf16_t*)(ws + WS_BR), (const bf16_t*)(ws + WS_WBR + (size_t)l * SZ_WSQ), D, D, k_, 0};
              pg8::MergeOrder S_; { int g2_ = gridDim.x, c2_ = blockIdx.x; asm volatile("" : "+s"(g2_), "+s"(c2_)); S_.S.init(NMO, 16, g2_, c2_); E.SCR = ws + WS_MRG + (size_t)c2_ * 131072; }
              pg8::gemm_phase<EpiMerge2>(lds, g_, S_, E); }
            if (l == 0) tail_items(F, args, 1056, 12000, 15700); SEAM(pb + 8); }
        if (EN(9) && IN(pb + 9)) { PHASE_BEGIN; EpiResid E{(bf16_t*)(ws + WS_H), MODL + 5 * D, 1.0f, (l & 1)}; RUN_GEMM(EpiResid, E, ws + WS_U, ws + WS_WOUT + (size_t)l * SZ_WSQ, D, D, D, 0, NMO, 16); if (l == 0) tail_items(F, args, 1056, 15700, 23200); SEAM(pb + 9); }
        if (EN(10) && IN(pb + 10)) { PHASE_BEGIN; norm_phase(F, args, l, 6, NRO, false, false); SEAM(pb + 10); }
        if (EN(11) && IN(pb + 11)) { PHASE_BEGIN; EpiSwiglu E{(bf16_t*)(ws + WS_HID)}; RUN_GEMM(EpiSwiglu, E, ws + WS_U, ws + WS_W1IN + (size_t)(l * 2 + 1) * SZ_WFIN, D, D, D, 0, NMO, 48); if (l == 0) tail_items(F, args, 3168, 23200, 26500); SEAM(pb + 11); }
        if (EN(12) && IN(pb + 12)) { PHASE_BEGIN; EpiResid E{(bf16_t*)(ws + WS_H), MODL + 8 * D, 0.5f, 0}; RUN_GEMM(EpiResid, E, ws + WS_HID, ws + WS_W1OUT + (size_t)(l * 2 + 1) * SZ_WFOUT, HIDP, DFF, DFF, 0, NMO, 16); if (l == 0) tail_items(F, args, 1056, 26500, 35040); SEAM(pb + 12); }
    }
    if (EN(14) && IN(NPH - 1)) { PHASE_BEGIN; final_norm_phase(F, args); }
#undef IN
#undef EN
#undef SEAM
#undef RUN_GEMM
}


#ifndef DBG_STOP
#define DBG_STOP -1
#endif
#ifndef DBG_OFF
#define DBG_OFF (WS_WIN + (size_t)8192 * 4096 * 2)
#endif
#ifndef DBG_BF16
#define DBG_BF16 1
#endif
__global__ void dbg_dump(const unsigned char* src, int is_bf16, float* out, size_t n) {
    for (size_t i = (size_t)blockIdx.x * blockDim.x + threadIdx.x; i < n; i += (size_t)gridDim.x * blockDim.x) {
        float v = is_bf16 ? bf1(((const bf16_t*)src)[i]) : ((const float*)src)[i];
        if (!(v == v) || fabsf(v) > 1e30f) v = 12345.f;
        out[i] = v;
    }
}
extern "C" void kernel_launch(void* const* d_in, const int* in_sizes, int n_in, void* d_out, int out_size, void* d_ws, size_t ws_size, hipStream_t stream) {
    static int grid = 0;
    if (grid == 0) {
        if (n_in != 29 || out_size != ML * D || ws_size < WS_END) { fprintf(stderr, "kernel_launch: unexpected shapes (n_in %d out %d ws %zu need %zu)\n", n_in, out_size, ws_size, (size_t)WS_END); grid = -1; return; }
        int dev = 0, cus = 0, per_cu = 0;
        if (hipGetDevice(&dev) != hipSuccess || hipDeviceGetAttribute(&cus, hipDeviceAttributeMultiprocessorCount, dev) != hipSuccess) { grid = -1; return; }
        if (hipFuncSetAttribute((const void*)fwd_kernel, hipFuncAttributeMaxDynamicSharedMemorySize, LDS_BYTES) != hipSuccess) { fprintf(stderr, "kernel_launch: hipFuncSetAttribute failed\n"); grid = -1; return; }
        if (hipOccupancyMaxActiveBlocksPerMultiprocessor(&per_cu, (const void*)fwd_kernel, NTHR, LDS_BYTES) != hipSuccess || per_cu < 1) { fprintf(stderr, "kernel_launch: occupancy query says %d\n", per_cu); }
        (void)hipGetLastError();
        grid = cus > 0 ? cus : 256;
    }
    if (grid < 0) return;
    (void)hipMemsetAsync((char*)d_ws + WS_CTL, 0, CTL_BYTES, stream);
    Args a{};
    for (int i = 0; i < 29; ++i) a.in[i] = (const float*)d_in[i];
    a.out = (float*)d_out; a.ws = (unsigned char*)d_ws; a.pad = 0;
#if MK_ONE_LAUNCH
    a.ph_lo = 0; a.ph_hi = NPH; a.use_bar = 1;
    hipLaunchKernelGGL(fwd_kernel, dim3(grid), dim3(NTHR), LDS_BYTES, stream, a);
#else
    for (int ph = 0; ph < (DBG_STOP >= 0 ? DBG_STOP + 1 : NPH); ++ph) { a.ph_lo = ph; a.ph_hi = ph + 1; a.use_bar = 0; hipLaunchKernelGGL(fwd_kernel, dim3(grid), dim3(NTHR), LDS_BYTES, stream, a); }
#endif
#if DBG_STOP >= 0
    hipLaunchKernelGGL(dbg_dump, dim3(2048), dim3(256), 0, stream, (const unsigned char*)d_ws + (DBG_OFF), (int)(DBG_BF16), (float*)d_out, (size_t)ML * D);
#endif
}
```
